# Optimizing an MI355X kernel written in HIP

```python
import jax, jax.numpy as jnp
from jax import lax
import numpy as np

D_MODEL = 1024
BATCH = 8
SEQ = 2048
DEPTH = 4

HEAD_DIM = 64
MIX_WIDTH = D_MODEL
RET_WIDTH = MIX_WIDTH // 4
RET_HEADS = RET_WIDTH // HEAD_DIM
RET_CHUNK = 128
CONV_WIDTH = MIX_WIDTH // 4
CONV_K = 3
NSA_WIDTH = MIX_WIDTH // 2
NSA_HEADS = NSA_WIDTH // HEAD_DIM
NSA_KV_HEADS = 2
NSA_GROUP = NSA_HEADS // NSA_KV_HEADS
NSA_KV_WIDTH = NSA_KV_HEADS * HEAD_DIM
CMP_LEN = 32
CMP_STRIDE = 16
CMP_HIDDEN = 2 * HEAD_DIM
SEL_LEN = 64
SEL_TOP = 8
WINDOW = 512
Q_BLOCK = 128
ROPE_THETA = 10000.0
N_EXPERTS = 32
TOP_K = 4
D_EXPERT = D_MODEL
SWIGLU_LIMIT = 7.0
SWIGLU_ALPHA = 1.702
MOE_BLOCK = 128
DEEPNORM_ALPHA = (2 * DEPTH) ** 0.25
DEEPNORM_BETA = (8 * DEPTH) ** -0.25
LN_EPS = 1e-5
NEG_INF = -1e30
FORCE_SCORE = 1e9
MIX_SPLITS = (RET_WIDTH,) * 4 + (CONV_WIDTH,) * 3 + (NSA_WIDTH,) + (NSA_KV_WIDTH,) * 6 + (NSA_HEADS * 3,)
MIX_VALUE_COLS = (2, 6, 9, 11, 13)

kernel_name = 'hybrid_retention_conv_nsa_moe_trunk'


def layer_norm(x):
    xf = x.astype(jnp.float32)
    mu = jnp.mean(xf, -1, keepdims=True)
    var = jnp.mean(jnp.square(xf - mu), -1, keepdims=True)
    return (xf - mu) * lax.rsqrt(var + LN_EPS)


def rope(t, positions):
    half = t.shape[-1] // 2
    inv = ROPE_THETA ** (-jnp.arange(half, dtype=jnp.float32) / half)
    ang = positions.astype(jnp.float32)[..., None] * inv
    cos = jnp.cos(ang)[:, :, None, :]
    sin = jnp.sin(ang)[:, :, None, :]
    t1 = t[..., :half].astype(jnp.float32)
    t2 = t[..., half:].astype(jnp.float32)
    return jnp.concatenate([t1 * cos - t2 * sin, t2 * cos + t1 * sin], -1).astype(t.dtype)


def retention(q, k, v, positions, gn_w):
    B, S, H, Dh = q.shape
    f32 = jnp.float32
    n_chunks = S // RET_CHUNK
    q = rope(q, positions).astype(f32)
    k = rope(k, positions).astype(f32) * Dh ** -0.5
    v = v.astype(f32)
    log_gamma = jnp.log(1.0 - jnp.power(2.0, -5.0 - jnp.arange(H, dtype=f32)))
    i = jnp.arange(RET_CHUNK, dtype=f32)
    diff = i[:, None] - i[None, :]
    intra = jnp.where(diff >= 0, jnp.exp(diff * log_gamma[:, None, None]), 0.0)
    q_dec = jnp.exp((i + 1.0) * log_gamma[:, None])[..., None]
    k_dec = jnp.exp((RET_CHUNK - 1.0 - i) * log_gamma[:, None])[..., None]
    c_dec = jnp.exp(RET_CHUNK * log_gamma)[:, None, None]

    def chunks(t):
        return t.reshape(B, n_chunks, RET_CHUNK, H, Dh).transpose(1, 0, 3, 2, 4)

    def step(state, qkv):
        qc, kc, vc = qkv
        scores = jnp.einsum('bhid,bhjd->bhij', qc, kc) * intra
        out = jnp.einsum('bhij,bhje->bhie', scores, vc) + jnp.einsum('bhid,bhde->bhie', qc * q_dec, state)
        state = state * c_dec + jnp.einsum('bhjd,bhje->bhde', kc * k_dec, vc)
        return state, out

    state0 = jnp.zeros((B, H, Dh, Dh), f32)
    _, out = lax.scan(step, state0, (chunks(q), chunks(k), chunks(v)))
    out = out.transpose(1, 0, 3, 2, 4)
    return layer_norm(out).reshape(B, S, H * Dh) * gn_w


def short_conv(b_gate, c_gate, h, conv_w):
    u = c_gate * h
    y = lax.conv_general_dilated(u, conv_w[:, None, :].astype(u.dtype), (1,), [(CONV_K - 1, 0)],
                                 dimension_numbers=('NWC', 'WIO', 'NWC'), feature_group_count=CONV_WIDTH)
    return b_gate * y


def nsa_attention(q, k_cmp, v_cmp, k_slc, v_slc, k_win, v_win, gate_logits, positions, cmp_pos, cmp_w1, cmp_w2):
    B, S = q.shape[:2]
    f32 = jnp.float32
    n_cmp = (S - CMP_LEN) // CMP_STRIDE + 1
    n_slc = S // SEL_LEN
    k_sel = min(SEL_TOP, n_slc)
    n_qb = S // Q_BLOCK
    scale = HEAD_DIM ** -0.5

    cidx = np.arange(n_cmp)[:, None] * CMP_STRIDE + np.arange(CMP_LEN)[None, :]

    def compress(t, pos, w1, w2):
        blocks = t[:, cidx] + pos[:, None, :]
        blocks = blocks.transpose(0, 1, 3, 2, 4).reshape(B, n_cmp, NSA_KV_HEADS, CMP_LEN * HEAD_DIM)
        return jax.nn.gelu(blocks @ w1) @ w2

    kc = compress(k_cmp, cmp_pos[0], cmp_w1[0], cmp_w2[0])
    vc = compress(v_cmp, cmp_pos[1], cmp_w1[1], cmp_w2[1])
    cmp_start = jnp.arange(n_cmp) * CMP_STRIDE
    cmp_last = cmp_start + CMP_LEN - 1
    sel_start = jnp.arange(n_slc) * SEL_LEN
    overlap = ((cmp_start[:, None] < sel_start[None, :] + SEL_LEN) &
               (sel_start[None, :] <= cmp_last[:, None])).astype(f32)

    q_grp = q.reshape(B, S, NSA_KV_HEADS, NSA_GROUP, HEAD_DIM)
    q_rot = rope(q, positions).reshape(B, S, NSA_KV_HEADS, NSA_GROUP, HEAD_DIM)
    k_slc = rope(k_slc, positions)
    k_win = rope(k_win, positions)
    ks_b = k_slc.reshape(B, n_slc, SEL_LEN, NSA_KV_HEADS, HEAD_DIM).transpose(0, 3, 1, 2, 4)
    vs_b = v_slc.reshape(B, n_slc, SEL_LEN, NSA_KV_HEADS, HEAD_DIM).transpose(0, 3, 1, 2, 4)
    pad = ((0, 0), (WINDOW, 0), (0, 0), (0, 0))
    kw_pad = jnp.pad(k_win, pad)
    vw_pad = jnp.pad(v_win, pad)
    gates = jax.nn.sigmoid(gate_logits.reshape(B, S, NSA_KV_HEADS, NSA_GROUP, 3))
    b_ix = jnp.arange(B)[:, None, None, None]
    h_ix = jnp.arange(NSA_KV_HEADS)[None, :, None, None]
    blk = jnp.arange(n_slc)

    def block(qb_idx):
        q0 = qb_idx * Q_BLOCK
        t = q0 + jnp.arange(Q_BLOCK)
        qu = lax.dynamic_slice_in_dim(q_grp, q0, Q_BLOCK, axis=1)
        qr = lax.dynamic_slice_in_dim(q_rot, q0, Q_BLOCK, axis=1)
        gb = lax.dynamic_slice_in_dim(gates, q0, Q_BLOCK, axis=1)
        s = jnp.einsum('bqhgd,bchd->bhgqc', qu, kc, preferred_element_type=f32) * scale
        cvalid = cmp_last[None, :] <= t[:, None]
        p_c = jax.nn.softmax(jnp.where(cvalid, s, NEG_INF), axis=-1) * cvalid
        o_c = jnp.einsum('bhgqc,bchd->bqhgd', p_c.astype(vc.dtype), vc)
        imp = jnp.einsum('bhgqc,cj->bhqj', p_c, overlap)
        forced = (blk[None, :] == 0) | (blk[None, :] == (t // SEL_LEN)[:, None])
        svalid = blk[None, :] * SEL_LEN <= t[:, None]
        imp = jnp.where(forced, FORCE_SCORE, jnp.where(svalid, imp, -FORCE_SCORE))
        _, sel = lax.top_k(imp, k_sel)
        kg = ks_b[b_ix, h_ix, sel]
        vg = vs_b[b_ix, h_ix, sel]
        kpos = sel[..., None] * SEL_LEN + jnp.arange(SEL_LEN)
        smask = (kpos <= t[None, None, :, None, None])[:, :, None]
        s = jnp.einsum('bqhgd,bhqkld->bhgqkl', qr, kg, preferred_element_type=f32) * scale
        s = jnp.where(smask, s, NEG_INF).reshape(B, NSA_KV_HEADS, NSA_GROUP, Q_BLOCK, k_sel * SEL_LEN)
        p_s = jax.nn.softmax(s, axis=-1).reshape(B, NSA_KV_HEADS, NSA_GROUP, Q_BLOCK, k_sel, SEL_LEN)
        o_s = jnp.einsum('bhgqkl,bhqkld->bqhgd', p_s.astype(vg.dtype), vg)
        kw = lax.dynamic_slice_in_dim(kw_pad, q0, WINDOW + Q_BLOCK, axis=1)
        vw = lax.dynamic_slice_in_dim(vw_pad, q0, WINDOW + Q_BLOCK, axis=1)
        wpos = q0 - WINDOW + jnp.arange(WINDOW + Q_BLOCK)
        rel = t[:, None] - wpos[None, :]
        wmask = (wpos[None, :] >= 0) & (rel >= 0) & (rel < WINDOW)
        s = jnp.einsum('bqhgd,bkhd->bhgqk', qr, kw, preferred_element_type=f32) * scale
        p_w = jax.nn.softmax(jnp.where(wmask, s, NEG_INF), axis=-1)
        o_w = jnp.einsum('bhgqk,bkhd->bqhgd', p_w.astype(vw.dtype), vw)
        o = gb[..., 0:1] * o_c + gb[..., 1:2] * o_s + gb[..., 2:3] * o_w
        return o.reshape(B, Q_BLOCK, NSA_WIDTH)

    out = lax.map(block, jnp.arange(n_qb))
    return out.transpose(1, 0, 2, 3).reshape(B, S, NSA_WIDTH)


def hybrid_mixer(h, positions, w_in, w_out, ret_gn_w, conv_w, cmp_pos, cmp_w1, cmp_w2):
    B, S, _ = h.shape
    points = [int(p) for p in np.cumsum(MIX_SPLITS)[:-1]]
    (rq, rk, rv, rg, cb, cc, ch, nq, nkc, nvc, nks, nvs, nkw, nvw, ng) = jnp.split(h @ w_in, points, axis=-1)

    def heads(t, n):
        return t.reshape(B, S, n, HEAD_DIM)

    y_ret = jax.nn.silu(rg) * retention(heads(rq, RET_HEADS), heads(rk, RET_HEADS), heads(rv, RET_HEADS),
                                        positions, ret_gn_w).astype(h.dtype)
    y_conv = short_conv(cb, cc, ch, conv_w)
    y_nsa = nsa_attention(heads(nq, NSA_HEADS), heads(nkc, NSA_KV_HEADS), heads(nvc, NSA_KV_HEADS),
                          heads(nks, NSA_KV_HEADS), heads(nvs, NSA_KV_HEADS), heads(nkw, NSA_KV_HEADS),
                          heads(nvw, NSA_KV_HEADS), ng, positions, cmp_pos, cmp_w1, cmp_w2)
    return jnp.concatenate([y_ret, y_conv, y_nsa], axis=-1) @ w_out


def moe_ffn(h, router_w, router_b, w_gu, b_gu, w_down, b_down):
    B, S, D = h.shape
    T = B * S
    xt = h.reshape(T, D)
    logits = (xt @ router_w).astype(jnp.float32) + router_b.astype(jnp.float32)
    top_val, top_idx = lax.top_k(logits, TOP_K)
    gate = jax.nn.softmax(top_val, axis=-1)
    flat_e = top_idx.reshape(-1)
    flat_tok = jnp.repeat(jnp.arange(T, dtype=jnp.int32), TOP_K)
    flat_w = gate.reshape(-1)
    order = jnp.argsort(flat_e)
    se = flat_e[order]
    counts = jnp.bincount(flat_e, length=N_EXPERTS)
    start = jnp.cumsum(counts) - counts
    padded = (counts + MOE_BLOCK - 1) // MOE_BLOCK * MOE_BLOCK
    pend = jnp.cumsum(padded)
    pstart = pend - padded
    dest = pstart[se] + jnp.arange(T * TOP_K) - start[se]
    n_rows = T * TOP_K + N_EXPERTS * MOE_BLOCK
    n_blocks = n_rows // MOE_BLOCK
    row_tok = jnp.full((n_rows,), T, jnp.int32).at[dest].set(flat_tok[order])
    row_w = jnp.zeros((n_rows,), jnp.float32).at[dest].set(flat_w[order])
    block_e = jnp.minimum(jnp.searchsorted(pend, jnp.arange(n_blocks) * MOE_BLOCK, side='right'), N_EXPERTS - 1)
    rows = jnp.concatenate([xt, jnp.zeros((1, D), xt.dtype)], 0)[row_tok].reshape(n_blocks, MOE_BLOCK, D)

    def expert_block(args):
        r, e = args
        gu = r @ w_gu[e] + b_gu[e]
        g = jnp.minimum(gu[:, :D_EXPERT], SWIGLU_LIMIT)
        u = jnp.clip(gu[:, D_EXPERT:], -SWIGLU_LIMIT, SWIGLU_LIMIT)
        act = (u + 1.0) * (g * jax.nn.sigmoid(SWIGLU_ALPHA * g))
        return act @ w_down[e] + b_down[e]

    y = lax.map(expert_block, (rows, block_e)).reshape(n_rows, D)
    y = jax.ops.segment_sum(y.astype(jnp.float32) * row_w[:, None], row_tok, num_segments=T + 1)[:T]
    return y.astype(h.dtype).reshape(B, S, D)


def setup_inputs(seed: int = 0) -> dict:
    key = jax.random.key(seed)
    ks = jax.random.split(key, 20)
    f32 = jnp.float32

    def nrm(k, shape, s):
        return jax.random.normal(k, shape, f32) * s

    n_in = sum(MIX_SPLITS)
    col_scale = np.concatenate([np.full((w,), DEEPNORM_BETA if i in MIX_VALUE_COLS else 1.0, np.float32)
                                for i, w in enumerate(MIX_SPLITS)])
    x = nrm(ks[0], (BATCH, SEQ, D_MODEL), 1.0)
    c = nrm(ks[1], (BATCH, D_MODEL), 1.0)
    positions = (jnp.arange(SEQ, dtype=jnp.int32)[None, :] +
                 jax.random.randint(ks[2], (BATCH, 1), 0, 4096, dtype=jnp.int32))
    w_in = nrm(ks[3], (DEPTH, D_MODEL, n_in), D_MODEL ** -0.5) * jnp.asarray(col_scale)
    w_out = nrm(ks[4], (DEPTH, MIX_WIDTH, D_MODEL), MIX_WIDTH ** -0.5 * DEEPNORM_BETA)
    ret_gn_w = 1.0 + nrm(ks[5], (DEPTH, RET_WIDTH), 0.02)
    conv_w = nrm(ks[6], (DEPTH, CONV_K, CONV_WIDTH), CONV_K ** -0.5)
    cmp_pos = nrm(ks[7], (DEPTH, 2, CMP_LEN, HEAD_DIM), 0.02)
    cmp_w1 = nrm(ks[8], (DEPTH, 2, CMP_LEN * HEAD_DIM, CMP_HIDDEN), (CMP_LEN * HEAD_DIM) ** -0.5)
    cmp_w2 = nrm(ks[9], (DEPTH, 2, CMP_HIDDEN, HEAD_DIM), CMP_HIDDEN ** -0.5)
    ada_w = nrm(ks[10], (DEPTH, D_MODEL, 6 * D_MODEL), 0.01)
    ada_b = nrm(ks[11], (DEPTH, 6 * D_MODEL), 0.01)
    ln_g = 1.0 + nrm(ks[12], (DEPTH, 2, D_MODEL), 0.02)
    ln_b = nrm(ks[13], (DEPTH, 2, D_MODEL), 0.02)
    router_w = nrm(ks[14], (DEPTH, D_MODEL, N_EXPERTS), D_MODEL ** -0.5)
    router_b = nrm(ks[15], (DEPTH, N_EXPERTS), 0.01)
    w_gate_up = nrm(ks[16], (DEPTH, N_EXPERTS, D_MODEL, 2 * D_EXPERT), D_MODEL ** -0.5 * DEEPNORM_BETA)
    b_gate_up = nrm(ks[17], (DEPTH, N_EXPERTS, 2 * D_EXPERT), 0.01)
    w_down = nrm(ks[18], (DEPTH, N_EXPERTS, D_EXPERT, D_MODEL), D_EXPERT ** -0.5 * DEEPNORM_BETA)
    b_down = nrm(ks[19], (DEPTH, N_EXPERTS, D_MODEL), 0.01)
    return {'x': x, 'c': c, 'positions': positions, 'w_in': w_in, 'w_out': w_out, 'ret_gn_w': ret_gn_w,
            'conv_w': conv_w, 'cmp_pos': cmp_pos, 'cmp_w1': cmp_w1, 'cmp_w2': cmp_w2, 'ada_w': ada_w,
            'ada_b': ada_b, 'ln_g': ln_g, 'ln_b': ln_b, 'router_w': router_w, 'router_b': router_b,
            'w_gate_up': w_gate_up, 'b_gate_up': b_gate_up, 'w_down': w_down, 'b_down': b_down}


def reference(x, c, positions, w_in, w_out, ret_gn_w, conv_w, cmp_pos, cmp_w1, cmp_w2, ada_w, ada_b,
              ln_g, ln_b, router_w, router_b, w_gate_up, b_gate_up, w_down, b_down):
    c_act = jax.nn.silu(c)
    for l in range(DEPTH):
        mod = c_act @ ada_w[l] + ada_b[l]
        sh1, sc1, g1, sh2, sc2, g2 = jnp.split(mod, 6, axis=-1)
        h = (layer_norm(x) * (1.0 + sc1[:, None, :]) + sh1[:, None, :]).astype(x.dtype)
        mix = hybrid_mixer(h, positions, w_in[l], w_out[l], ret_gn_w[l], conv_w[l], cmp_pos[l], cmp_w1[l], cmp_w2[l])
        x = (layer_norm(DEEPNORM_ALPHA * x + (1.0 + g1[:, None, :]) * mix) * ln_g[l, 0] + ln_b[l, 0]).astype(x.dtype)
        h = (layer_norm(x) * (1.0 + sc2[:, None, :]) + sh2[:, None, :]).astype(x.dtype)
        ffn = moe_ffn(h, router_w[l], router_b[l], w_gate_up[l], b_gate_up[l], w_down[l], b_down[l])
        x = (layer_norm(DEEPNORM_ALPHA * x + (1.0 + g2[:, None, :]) * ffn) * ln_g[l, 1] + ln_b[l, 1]).astype(x.dtype)
    return x
```

```cpp
#include <hip/hip_runtime.h>
#include <cstdio>
#include <cstdint>

#ifndef ONE_LAUNCH
#define ONE_LAUNCH 1
#endif

#define LAS __attribute__((address_space(3)))
typedef unsigned short bf16;
typedef short bf16x8 __attribute__((ext_vector_type(8)));
typedef float f32x4 __attribute__((ext_vector_type(4)));
typedef unsigned u32x4 __attribute__((ext_vector_type(4)));
typedef unsigned u32x2 __attribute__((ext_vector_type(2)));

constexpr int NB = 8, S = 2048, D = 1024, T = NB * S, DEPTH = 4;
constexpr int NIN = 3096, NINP = 3104, PLD = 3200;
constexpr int C_RQ = 0, C_RK = 256, C_RV = 512, C_RG = 768, C_CB = 1024, C_CC = 1280, C_CH = 1536, C_NQ = 1792,
              C_NKC = 2304, C_NVC = 2432, C_NKS = 2560, C_NVS = 2688, C_NKW = 2816, C_NVW = 2944, C_NG = 3072;
constexpr int NE = 32, TOPK = 4, FF = 1024;
constexpr float ALPHA = 1.681792830507429f, LN_EPS = 1e-5f;
constexpr int NWAVES = 8, NTHR = 512;

constexpr size_t MiB = 1u << 20;
constexpr size_t WS_CTL = 0, CTL_BYTES = 1 * MiB;
constexpr size_t WS_MOD = 1 * MiB;
constexpr size_t WS_ROPEC = 2 * MiB, WS_ROPES = 4 * MiB;
constexpr size_t WS_KC = 6 * MiB, WS_VC = 6 * MiB + 512 * 1024;
constexpr size_t WS_GATEW = 7 * MiB;
constexpr size_t WS_LIST = 8 * MiB;
constexpr size_t WS_WOUT = 16 * MiB;
constexpr size_t WS_WIN = 24 * MiB;
constexpr size_t WS_H = 64 * MiB;
constexpr size_t WS_Y = 96 * MiB;
constexpr size_t WS_MIX = 128 * MiB;
constexpr size_t WS_RQ = 192 * MiB, WS_RK = 208 * MiB;
constexpr size_t WS_NQR = 224 * MiB;
constexpr size_t WS_KSR = 256 * MiB, WS_KWR = 264 * MiB;
constexpr size_t WS_PROJ = 272 * MiB;
constexpr size_t WS_XB = 336 * MiB;
constexpr size_t WS_ACT = 480 * MiB;
constexpr size_t WS_YK = 640 * MiB;
constexpr size_t WS_WGU = 896 * MiB;
constexpr size_t WS_WDN = 1408 * MiB;
constexpr size_t WS_PRQ = 1664 * MiB, WS_PRK = 1672 * MiB, WS_PRV = 1680 * MiB;
constexpr size_t WS_RG = 1688 * MiB;
constexpr size_t WS_CV = 1696 * MiB;
constexpr size_t WS_NQU = 1720 * MiB, WS_NQRB = 1736 * MiB;
constexpr size_t WS_NKC = 1752 * MiB, WS_NVC = 1756 * MiB, WS_NKS = 1760 * MiB, WS_NVST = 1764 * MiB, WS_NKW = 1768 * MiB, WS_NVWT = 1772 * MiB;
constexpr size_t WS_NG = 1776 * MiB;
constexpr size_t WS_KVB = 1780 * MiB;
constexpr size_t WS_KCB = 1788 * MiB, WS_VCT = 1789 * MiB;
constexpr size_t WS_CW1T = 1790 * MiB, WS_CW2T = 1794 * MiB, WS_CB1 = 1795 * MiB;
constexpr size_t WS_RWT = 1796 * MiB;
constexpr size_t WS_END = 1800 * MiB;
constexpr size_t WS_HQ = 192 * MiB;
constexpr size_t WS_HS = 208 * MiB;
constexpr size_t WS_LHS = 210 * MiB, WS_LGW = 212 * MiB;
constexpr int CW_WMAX = 2048;
constexpr float NSA_QS = 0.125f * 1.4426950408889634f;
constexpr float ACT_QS = 8.f;
constexpr bool FAST_RET = true, FAST_NSA = true;
constexpr bool KEEP_PROJ = !FAST_NSA;
constexpr int CW_CNT = 1024;
constexpr int CW_BAR = 4096;

constexpr int LDS_MISC = 131072;
constexpr int LDS_BYTES = 147456;

#define XB_TMO      128
#define XB_XCNT(j)  (256  + 64 * (j))
#define XB_XSUB(j)  (1280 + 64 * (j))
#define XB_XGEN(j)  (2304 + 64 * (j))
#define XB_TOP      3328
#define XB_TOPGEN   3392
#define XCD_BAR_WORDS 3456
#define XB_SPIN_CAP (1u << 18)
__device__ __forceinline__ unsigned xb_ld(unsigned* p)              { return __hip_atomic_load(p, __ATOMIC_RELAXED, __HIP_MEMORY_SCOPE_AGENT); }
__device__ __forceinline__ unsigned xb_add(unsigned* p, unsigned v) { return __hip_atomic_fetch_add(p, v, __ATOMIC_RELAXED, __HIP_MEMORY_SCOPE_AGENT); }
__device__ __forceinline__ unsigned xb_xcc_id() { return (unsigned)__builtin_amdgcn_s_getreg((3 << 11) | 20) & 0xFu; }
#define XB_SPIN(cond, bar) do { unsigned _sp = 0; while (cond) { __builtin_amdgcn_s_sleep(1); \
    if ((++_sp & 255u) == 0u) { if (xb_ld(&(bar)[XB_TMO])) break; if (_sp > XB_SPIN_CAP) { atomicAdd(&(bar)[XB_TMO], 1u); break; } } } } while (0)
struct XcdBarrier { unsigned* bar; unsigned x; volatile LAS unsigned* st; };
__device__ __forceinline__ XcdBarrier xcd_barrier_post(unsigned* bar, volatile LAS unsigned* st, const bool is_t0) {
    XcdBarrier b; b.bar = bar; b.x = xb_xcc_id(); b.st = st;
    if (is_t0) (void)xb_add(&bar[XB_XCNT(b.x)], 1u);
    return b;
}
__device__ __forceinline__ void xcd_barrier_complete(unsigned* bar, unsigned x, unsigned& nloc, unsigned& nx) {
    const unsigned G = gridDim.x * gridDim.y * gridDim.z;
    unsigned sum, cnt, mine, sp = 0u;
    for (;;) {
        sum = 0u; cnt = 0u; mine = 0u;
#pragma unroll
        for (unsigned j = 0; j < 16; ++j) { const unsigned c = xb_ld(&bar[XB_XCNT(j)]); sum += c; cnt += (c > 0u) ? 1u : 0u; mine = (j == x) ? c : mine; }
        if (sum == G) break;
        __builtin_amdgcn_s_sleep(1);
        if ((++sp & 255u) == 0u) { if (xb_ld(&bar[XB_TMO])) break; if (sp > XB_SPIN_CAP) { atomicAdd(&bar[XB_TMO], 1u); break; } }
    }
    nloc = mine > 0u ? mine : 1u; nx = cnt > 0u ? cnt : 1u;
}
__device__ __forceinline__ void xcd_barrier(const XcdBarrier& b, const bool is_t0) {
    asm volatile("s_waitcnt vmcnt(0)" ::: "memory");
    __syncthreads();
    if (is_t0) {
        unsigned* bar = b.bar;
        __builtin_amdgcn_s_waitcnt(0);
        unsigned nloc = b.st[0], nx = b.st[1];
        if (nloc == 0u) { xcd_barrier_complete(bar, b.x, nloc, nx); b.st[0] = nloc; b.st[1] = nx; }
        const unsigned old = xb_add(&bar[XB_XSUB(b.x)], 1u);
        const unsigned gen = old / nloc;
        if (old + 1u == (gen + 1u) * nloc) {
            __builtin_amdgcn_fence(__ATOMIC_RELEASE, "agent");
            asm volatile("s_waitcnt vmcnt(0)" ::: "memory");
            const unsigned og = xb_add(&bar[XB_TOP], 1u);
            const unsigned tg = og / nx;
            if (og + 1u == (tg + 1u) * nx) xb_add(&bar[XB_TOPGEN], 1u);
            else XB_SPIN(xb_ld(&bar[XB_TOPGEN]) == tg, bar);
            __builtin_amdgcn_fence(__ATOMIC_ACQUIRE, "agent");
            xb_add(&bar[XB_XGEN(b.x)], 1u);
            asm volatile("s_waitcnt vmcnt(0)" ::: "memory");
        } else {
            XB_SPIN(xb_ld(&bar[XB_XGEN(b.x)]) == gen, bar);
            __builtin_amdgcn_fence(__ATOMIC_ACQUIRE, "agent");
            asm volatile("s_waitcnt vmcnt(0)" ::: "memory");
        }
    }
    __syncthreads();
}

#define LDS_WAIT() asm volatile("s_waitcnt lgkmcnt(0)" ::: "memory")
#define LDS_BARRIER() do { asm volatile("s_waitcnt lgkmcnt(0)" ::: "memory"); __builtin_amdgcn_s_barrier(); asm volatile("" ::: "memory"); } while (0)
__device__ __forceinline__ unsigned cvt_pk_bf16(float lo, float hi) { unsigned r; asm("v_cvt_pk_bf16_f32 %0, %1, %2" : "=v"(r) : "v"(lo), "v"(hi)); return r; }
__device__ __forceinline__ float wsum(float v) {
#pragma unroll
    for (int o = 32; o >= 1; o >>= 1) v += __shfl_xor(v, o);
    return v;
}
__device__ __forceinline__ float wmaxf(float v) {
#pragma unroll
    for (int o = 32; o >= 1; o >>= 1) v = fmaxf(v, __shfl_xor(v, o));
    return v;
}
__device__ __forceinline__ void wargmax(float& v, int& i) {
#pragma unroll
    for (int o = 32; o >= 1; o >>= 1) {
        const float ov = __shfl_xor(v, o); const int oi = __shfl_xor(i, o);
        const bool take = (ov > v) || (ov == v && oi < i);
        v = take ? ov : v; i = take ? oi : i;
    }
}
__device__ __forceinline__ float w_qscale(float wmax) { return exp2f(floorf(log2f(128.f / fmaxf(wmax, 1e-30f)))); }
__device__ __forceinline__ unsigned pk4_fp8(f32x4 v) { int r = 0; r = __builtin_amdgcn_cvt_pk_fp8_f32(v.x, v.y, r, false); r = __builtin_amdgcn_cvt_pk_fp8_f32(v.z, v.w, r, true); return (unsigned)r; }
__device__ __forceinline__ float dot4(f32x4 a, f32x4 b) { return a.x * b.x + a.y * b.y + a.z * b.z + a.w * b.w; }
__device__ __forceinline__ float sigmoidf_(float x) { return 1.f / (1.f + expf(-x)); }

struct Args { const float* in[20]; float* out; unsigned char* ws; int ph_lo, ph_hi; };
#define GAS __attribute__((address_space(1)))
struct Frame {
    LAS unsigned char* lds;
    GAS unsigned char* ws;
    const float* const* in;
    GAS float* out;
    int tid, lane, wave, bid, G;
};

__device__ __forceinline__ int hw_lane() { return (int)__builtin_amdgcn_mbcnt_hi(~0u, __builtin_amdgcn_mbcnt_lo(~0u, 0u)); }
__device__ __forceinline__ Frame launder(const Frame& F) {
    Frame G = F;
    asm volatile("" : "+v"(G.tid));
    G.lane = G.tid & 63; G.wave = __builtin_amdgcn_readfirstlane(G.tid >> 6);
    asm volatile("" : "+s"(G.ws), "+s"(G.out));

    return G;
}
__constant__ double c_inv_freq[32] = {
    1.0, 0.7498942093324559, 0.5623413251903491, 0.4216965034285822,
    0.31622776601683794, 0.23713737056616552, 0.1778279410038923, 0.1333521432163324,
    0.1, 0.07498942093324558, 0.05623413251903491, 0.042169650342858224,
    0.03162277660168379, 0.023713737056616554, 0.01778279410038923, 0.01333521432163324,
    0.01, 0.007498942093324558, 0.005623413251903491, 0.004216965034285823,
    0.0031622776601683794, 0.0023713737056616554, 0.0017782794100389228, 0.001333521432163324,
    0.001, 0.0007498942093324559, 0.0005623413251903491, 0.00042169650342858224,
    0.00031622776601683794, 0.00023713737056616554, 0.00017782794100389227, 0.0001333521432163324};

__device__ __forceinline__ int perm32s(int c) { return (c & ~31) + (((c >> 2) & 1) << 4) + (((c & 31) >> 3) << 2) + (c & 3); }
template <int MAP> __device__ __forceinline__ int map_row(int n) {
    if (MAP == 0) return n;
    if (MAP == 3) return perm32s(n);
    if (MAP == 1) { const int half = n >> 10, j = n & 1023; return ((j >> 7) << 8) + (half << 7) + perm32s(j & 127); }
    if (n >= 3072) return n;
    const int w = n & 255; return (n & ~255) + (((w >> 5) & 1) << 7) + ((w >> 6) << 5) + perm32s(w & 31);
}
typedef float f32x2 __attribute__((ext_vector_type(2)));
struct TItem { const float* W; bf16* WT; int K, N, Npad, map, k0, n0; };
__device__ __forceinline__ int map_row_rt(int map, int n) { return map == 0 ? n : (map == 1 ? map_row<1>(n) : (map == 3 ? map_row<3>(n) : map_row<2>(n))); }
__device__ __forceinline__ bool titem_decode(const Frame& F, int it, TItem& t) {
    constexpr int B_IN = (NINP + 63) / 64, I_IN = 16 * B_IN, I_OUT = 16 * 16, I_GU = 16 * 32, I_DN = 16 * 16, I_C1 = 32 * 2, I_C2 = 2 * 1;
    constexpr int N_IN = DEPTH * I_IN, N_OUT = DEPTH * I_OUT, N_GU = DEPTH * NE * I_GU, N_DN = DEPTH * NE * I_DN, N_C1 = 8 * I_C1, N_C2 = 8 * I_C2;
    int r = it, nblk, item;
    if (r < N_IN) { const int l = r / I_IN; t.W = F.in[3] + (size_t)l * D * NIN; t.WT = (bf16*)(F.ws + WS_WIN) + (size_t)l * NINP * D; t.K = D; t.N = NIN; t.Npad = NINP; t.map = 2; nblk = B_IN; item = r % I_IN; }
    else if ((r -= N_IN) < N_OUT) { const int l = r / I_OUT; t.W = F.in[4] + (size_t)l * D * D; t.WT = (bf16*)(F.ws + WS_WOUT) + (size_t)l * D * D; t.K = D; t.N = D; t.Npad = D; t.map = 3; nblk = 16; item = r % I_OUT; }
    else if ((r -= N_OUT) < N_C1) { const int lw = r / I_C1; t.W = F.in[8] + (size_t)lw * 2048 * 128; t.WT = (bf16*)(F.ws + WS_CW1T) + (size_t)lw * 128 * 2048; t.K = 2048; t.N = 128; t.Npad = 128; t.map = 0; nblk = 2; item = r % I_C1; }
    else if ((r -= N_C1) < N_C2) { const int lw = r / I_C2; t.W = F.in[9] + (size_t)lw * 128 * 64; t.WT = (bf16*)(F.ws + WS_CW2T) + (size_t)lw * 64 * 128; t.K = 128; t.N = 64; t.Npad = 64; t.map = 0; nblk = 1; item = r % I_C2; }
    else return false;
    t.k0 = 64 * (item / nblk); t.n0 = 64 * (item % nblk); return true;
}
__device__ __forceinline__ void titem_load(const TItem& t, int lane, f32x2 (&v)[32]) {
    const int nn = t.n0 + 2 * (lane & 31);
    const float* wp = t.W + (size_t)(t.k0 + (lane >> 5)) * t.N + (nn < t.N ? nn : 0);
#pragma unroll
    for (int q = 0; q < 32; ++q) v[q] = __builtin_nontemporal_load((const f32x2*)(wp + (size_t)(2 * q) * t.N));
}
__device__ __forceinline__ void titem_store(const TItem& t, int lane, const f32x2 (&v)[32], LAS unsigned* scr) {
    const int np = lane & 31; const bool inb = t.n0 + 2 * np < t.N;
#pragma unroll
    for (int q = 0; q < 32; ++q) scr[(2 * q + (lane >> 5)) * 33 + np] = inb ? cvt_pk_bf16(v[q].x, v[q].y) : 0u;
    LDS_WAIT();
    const int c = lane & 7;
#pragma unroll
    for (int j = 0; j < 8; ++j) { const int n = 8 * j + (lane >> 3); const LAS unsigned* sp = scr + (8 * c) * 33 + (n >> 1); const int sh = (n & 1) * 16;
        unsigned e[8];
#pragma unroll
        for (int i = 0; i < 8; ++i) e[i] = (sp[i * 33] >> sh) & 0xffffu;
        u32x4 o; o.x = e[0] | (e[1] << 16); o.y = e[2] | (e[3] << 16); o.z = e[4] | (e[5] << 16); o.w = e[6] | (e[7] << 16);
        if (t.n0 + n < t.Npad) *(u32x4*)(t.WT + (size_t)map_row_rt(t.map, t.n0 + n) * t.K + t.k0 + 8 * c) = o; }
    LDS_WAIT();
}

struct TItem8 { const float* W; unsigned char* WT; int N, map, k0, n0; float scale; };
__device__ __forceinline__ bool titem8_decode(const Frame& F, int l, int it, TItem8& t) {
    constexpr int I_GU = 8 * 64, I_DN = 8 * 32, N_GU = NE * I_GU, N_DN = NE * I_DN;
    const float* wmax = (const float*)((const unsigned*)(F.ws + WS_CTL) + CW_WMAX);
    int r = it, nblk, item;
    if (r < 0) return false;
    if (r < N_GU) { const int le = l * NE + r / I_GU; t.W = F.in[16] + (size_t)le * D * 2048; t.WT = (unsigned char*)(F.ws + WS_WGU) + (size_t)le * 2048 * D; t.N = 2048; t.map = 1; nblk = 64; item = r % I_GU; t.scale = w_qscale(wmax[(le >> 5) * 2 + 0]); }
    else if ((r -= N_GU) < N_DN) { const int le = l * NE + r / I_DN; t.W = F.in[18] + (size_t)le * FF * D; t.WT = (unsigned char*)(F.ws + WS_WDN) + (size_t)le * D * FF; t.N = D; t.map = 3; nblk = 32; item = r % I_DN; t.scale = w_qscale(wmax[(le >> 5) * 2 + 1]); }
    else return false;
    t.k0 = 128 * (item / nblk); t.n0 = 32 * (item % nblk); return true;
}
__device__ __forceinline__ void titem8_load(const TItem8& t, int lane, float (&v)[64]) {
    const float* wp = t.W + (size_t)(t.k0 + (lane >> 5)) * t.N + t.n0 + (lane & 31);
#pragma unroll
    for (int q = 0; q < 64; ++q) v[q] = __builtin_nontemporal_load(wp + (size_t)(2 * q) * t.N);
}
__device__ __forceinline__ void titem8_store(const TItem8& t, int lane, const float (&v)[64], LAS unsigned char* scr) {
    LAS unsigned char* rowp = scr + (lane & 31) * 132 + (lane >> 5);
#pragma unroll
    for (int q = 0; q < 64; q += 2) { const int r = __builtin_amdgcn_cvt_pk_fp8_f32(v[q] * t.scale, v[q + 1] * t.scale, 0, false);
        rowp[2 * q] = (unsigned char)(r & 0xff); rowp[2 * q + 2] = (unsigned char)((r >> 8) & 0xff); }
    LDS_WAIT();
    const int c = lane & 7;
#pragma unroll
    for (int j = 0; j < 4; ++j) { const int n = 8 * j + (lane >> 3); const LAS unsigned* sp = (const LAS unsigned*)(scr + n * 132 + 16 * c);
        u32x4 o; o.x = sp[0]; o.y = sp[1]; o.z = sp[2]; o.w = sp[3];
        *(u32x4*)(t.WT + (size_t)map_row_rt(t.map, t.n0 + n) * D + t.k0 + 16 * c) = o; }
    LDS_WAIT();
}
struct WItem { const float* W; unsigned char* WT; int N, map, k0, n0; float scale; };
__device__ __forceinline__ bool witem_decode(const Frame& F, int l, int it, WItem& t) {
    constexpr int I_GU = 4 * 16, I_DN = 4 * 8, N_GU = NE * I_GU, N_DN = NE * I_DN;
    const float* wmax = (const float*)((const unsigned*)(F.ws + WS_CTL) + CW_WMAX);
    int r = it, nblk, item;
    if (r < N_GU) { const int le = l * NE + r / I_GU; t.W = F.in[16] + (size_t)le * D * 2048; t.WT = (unsigned char*)(F.ws + WS_WGU) + (size_t)le * 2048 * D; t.N = 2048; t.map = 1; nblk = 16; item = r % I_GU; t.scale = w_qscale(wmax[l * 2 + 0]); }
    else if ((r -= N_GU) < N_DN) { const int le = l * NE + r / I_DN; t.W = F.in[18] + (size_t)le * FF * D; t.WT = (unsigned char*)(F.ws + WS_WDN) + (size_t)le * D * FF; t.N = D; t.map = 3; nblk = 8; item = r % I_DN; t.scale = w_qscale(wmax[l * 2 + 1]); }
    else return false;
    t.k0 = 256 * (item / nblk); t.n0 = 128 * (item % nblk); return true;
}
__device__ __forceinline__ void witem_load(const WItem& t, int wave, int lane, f32x4 (&v)[16]) {
    const float* wp = t.W + (size_t)(t.k0 + 32 * wave + 16 * (lane >> 5)) * t.N + t.n0 + 4 * (lane & 31);
#pragma unroll
    for (int q = 0; q < 16; ++q) v[q] = __builtin_nontemporal_load((const f32x4*)(wp + (size_t)q * t.N));
}
__device__ __forceinline__ void witem_store(const Frame& F, const WItem& t, const f32x4 (&v)[16], LAS unsigned char* tile) {
    const int i = F.lane & 31, hi = F.lane >> 5;
#pragma unroll
    for (int j = 0; j < 4; ++j) {
        u32x4 o;
#pragma unroll
        for (int d = 0; d < 4; ++d) { int r = __builtin_amdgcn_cvt_pk_fp8_f32(v[4 * d][j] * t.scale, v[4 * d + 1][j] * t.scale, 0, false);
            r = __builtin_amdgcn_cvt_pk_fp8_f32(v[4 * d + 2][j] * t.scale, v[4 * d + 3][j] * t.scale, r, true); o[d] = (unsigned)r; }
        *(LAS u32x4*)(tile + (32 * j + i) * 272 + 32 * F.wave + 16 * hi) = o;
    }
    __syncthreads();
    const int c = F.tid & 15;
#pragma unroll
    for (int pass = 0; pass < 4; ++pass) { const int n = (F.tid >> 4) + 32 * pass, rho = (n & 3) * 32 + (n >> 2);
        const u32x4 o = *(const LAS u32x4*)(tile + rho * 272 + 16 * c);
        *(u32x4*)(t.WT + (size_t)map_row_rt(t.map, t.n0 + n) * D + t.k0 + 16 * c) = o; }
}
constexpr int CONV_ITEMS = NE * (4 * 16 + 4 * 8);
constexpr int CONV_SPLIT = CONV_ITEMS / 2;
__device__ __forceinline__ void fp8_convert_range(const Frame& F, int l, int start, int stride, int limit) {
    __syncthreads();
    WItem ta, tb; f32x4 va[16], vb[16];
    int it = start;
    bool ha = it < limit && witem_decode(F, l, it, ta);
    if (ha) witem_load(ta, F.wave, F.lane, va);
    while (ha) {
        const bool hb = it + stride < limit && witem_decode(F, l, it + stride, tb);
        if (hb) witem_load(tb, F.wave, F.lane, vb);
        witem_store(F, ta, va, F.lds);
        if (!hb) break;
        it += 2 * stride;
        ha = it < limit && witem_decode(F, l, it, ta);
        if (ha) witem_load(ta, F.wave, F.lane, va);
        witem_store(F, tb, vb, F.lds + 34816);
    }
    __syncthreads();
}
__device__ __forceinline__ void sample_wmax(const Frame& F) {
    const int gw = F.bid * NWAVES + F.wave, NGW = F.G * NWAVES, lane = F.lane;
    for (int task = gw; task < 2048; task += NGW) { const int le = task >> 4, part = task & 15;
        float mg = 0.f, md = 0.f;
#pragma unroll
        for (int i = 0; i < 1; ++i) { const int k = 64 * part + 16 * i;
            const float* g = F.in[16] + ((size_t)le * D + k) * 2048 + lane * 4; const float* dn = F.in[18] + ((size_t)le * FF + k) * D + lane * 4;
#pragma unroll
            for (int j = 0; j < 8; ++j) { const f32x4 v = *(const f32x4*)(g + 256 * j); mg = fmaxf(mg, fmaxf(fmaxf(fabsf(v.x), fabsf(v.y)), fmaxf(fabsf(v.z), fabsf(v.w)))); }
#pragma unroll
            for (int j = 0; j < 4; ++j) { const f32x4 v = *(const f32x4*)(dn + 256 * j); md = fmaxf(md, fmaxf(fmaxf(fabsf(v.x), fabsf(v.y)), fmaxf(fabsf(v.z), fabsf(v.w)))); } }
        mg = wmaxf(mg); md = wmaxf(md);
        LAS float* rd = (LAS float*)F.lds;
        __syncthreads();
        if (lane == 0) { rd[F.wave * 2] = mg; rd[F.wave * 2 + 1] = md; }
        __syncthreads();
        if (F.tid < 2) { float m = 0.f;
#pragma unroll
            for (int w2 = 0; w2 < 8; ++w2) m = fmaxf(m, rd[w2 * 2 + F.tid]);
            atomicMax((unsigned*)(F.ws + WS_CTL) + CW_WMAX + (le >> 5) * 2 + F.tid, __float_as_uint(m)); }
    }
    __syncthreads();
}

__device__ __forceinline__ void phase_p0(const Frame& F) {
    sample_wmax(F);
    LAS unsigned* scr = (LAS unsigned*)(F.lds + F.wave * 16384);
    const int gw = F.bid * NWAVES + F.wave, NGW = F.G * NWAVES;
    {
        TItem ta, tb; f32x2 va[32], vb[32];
        int it = gw;
        bool ha = titem_decode(F, it, ta);
        if (ha) titem_load(ta, F.lane, va);
        while (ha) {
            const bool hb = titem_decode(F, it + NGW, tb);
            if (hb) titem_load(tb, F.lane, vb);
            titem_store(ta, F.lane, va, scr);
            if (!hb) break;
            it += 2 * NGW;
            ha = titem_decode(F, it, ta);
            if (ha) titem_load(ta, F.lane, va);
            titem_store(tb, F.lane, vb, scr);
        }
    }
    __syncthreads();
    { LAS float* red = (LAS float*)F.lds;
      for (int it = (F.G >= 256 ? F.bid - (F.G - 16) : F.bid); it >= 0 && it < 16; it += F.G) { const int lw = it >> 1, n = (it & 1) * 64 + F.lane; float a = 0.f;
        const float* pos = F.in[7] + (size_t)lw * 2048 + F.wave * 256; const float* w1 = F.in[8] + ((size_t)lw * 2048 + F.wave * 256) * 128 + n;
#pragma unroll 16
        for (int k = 0; k < 256; ++k) a += pos[k] * w1[(size_t)k * 128];
        red[F.wave * 64 + F.lane] = a;
        __syncthreads();
        if (F.wave == 0) { float sm = 0.f;
#pragma unroll
            for (int w2 = 0; w2 < 8; ++w2) sm += red[w2 * 64 + F.lane];
            ((float*)(F.ws + WS_CB1))[lw * 128 + n] = sm; }
        __syncthreads(); } }
    for (int i = F.bid * NTHR + F.tid; i < DEPTH * NE * D; i += F.G * NTHR) { const int k = i & (D - 1), e = (i >> 10) & (NE - 1), l2 = i >> 15;
        ((float*)(F.ws + WS_RWT))[i] = F.in[14][((size_t)l2 * D + k) * NE + e]; }
    for (int i = F.bid * NTHR + F.tid; i < T * 32; i += F.G * NTHR) {
        const int tok = i >> 5, f = i & 31;
        const double ang = (double)((const int*)F.in[2])[tok] * c_inv_freq[f];
        const double k = rint(ang * 0.15915494309189535);
        const float r = (float)(ang - k * 6.283185307179586);
        ((float*)(F.ws + WS_ROPEC))[i] = cosf(r); ((float*)(F.ws + WS_ROPES))[i] = sinf(r);
    }
    __syncthreads();
    LAS float* red = (LAS float*)F.lds;
    LAS float* sil = (LAS float*)(F.lds + 65536);
    for (int i = F.tid; i < NB * D; i += NTHR) { const float cv = F.in[1][i]; sil[i] = cv * sigmoidf_(cv); }
    __syncthreads();
    typedef float f32x2v __attribute__((ext_vector_type(2)));
    for (int it = F.bid; it < DEPTH * 48; it += F.G) {
        const int l = it / 48, n0 = (it % 48) * 128 + 2 * F.lane;
        f32x2v acc[8];
#pragma unroll
        for (int b = 0; b < 8; ++b) acc[b] = (f32x2v){0.f, 0.f};
        const float* w = F.in[10] + (size_t)l * D * 6144 + n0;
        for (int k0 = F.wave * 128; k0 < F.wave * 128 + 128; k0 += 16) {
            f32x2v wv[16];
#pragma unroll
            for (int q = 0; q < 16; ++q) wv[q] = __builtin_nontemporal_load((const f32x2v*)(w + (size_t)(k0 + q) * 6144));
#pragma unroll
            for (int q = 0; q < 16; ++q)
#pragma unroll
                for (int b = 0; b < 8; ++b) acc[b] += sil[b * D + k0 + q] * wv[q];
        }
        LAS f32x2v* red2 = (LAS f32x2v*)red;
#pragma unroll
        for (int b = 0; b < 8; ++b) red2[(F.wave * 8 + b) * 64 + F.lane] = acc[b];
        __syncthreads();
        { const int b = F.wave; f32x2v sm = {0.f, 0.f};
#pragma unroll
          for (int w2 = 0; w2 < 8; ++w2) sm += red2[(w2 * 8 + b) * 64 + F.lane];
          const f32x2v bia = *(const f32x2v*)(F.in[11] + l * 6144 + n0);
          *(f32x2v*)((float*)(F.ws + WS_MOD) + ((size_t)l * 8 + b) * 6144 + n0) = sm + bia; }
        __syncthreads();
    }
}

__device__ __forceinline__ void ln_stats(const f32x4 (&v)[4], float& mean, float& rstd) {
    float s = 0.f;
#pragma unroll
    for (int j = 0; j < 4; ++j) s += (v[j].x + v[j].y) + (v[j].z + v[j].w);
    mean = wsum(s) * (1.f / D);
    float s2 = 0.f;
#pragma unroll
    for (int j = 0; j < 4; ++j) { const f32x4 d = v[j] - mean; s2 += (d.x * d.x + d.y * d.y) + (d.z * d.z + d.w * d.w); }
    rstd = 1.f / sqrtf(wsum(s2) * (1.f / D) + LN_EPS);
}
__device__ __forceinline__ void load_row(const float* p, int lane, f32x4 (&v)[4]) {
#pragma unroll
    for (int j = 0; j < 4; ++j) v[j] = *(const f32x4*)(p + 256 * j + 4 * lane);
}
__device__ __forceinline__ void load_row_bf16(const bf16* p, int lane, f32x4 (&v)[4]) {
#pragma unroll
    for (int j = 0; j < 4; ++j) { const u32x2 q = *(const u32x2*)(p + 256 * j + 4 * lane);
        v[j] = (f32x4){__uint_as_float(q.x << 16), __uint_as_float(q.x & 0xffff0000u), __uint_as_float(q.y << 16), __uint_as_float(q.y & 0xffff0000u)}; }
}
__device__ __forceinline__ void store_row(float* p, int lane, const f32x4 (&v)[4]) {
#pragma unroll
    for (int j = 0; j < 4; ++j) *(f32x4*)(p + 256 * j + 4 * lane) = v[j];
}
__device__ __forceinline__ void store_row_bf16(bf16* p, int lane, const f32x4 (&v)[4]) {
#pragma unroll
    for (int j = 0; j < 4; ++j) { u32x2 o; o.x = cvt_pk_bf16(v[j].x, v[j].y); o.y = cvt_pk_bf16(v[j].z, v[j].w); *(u32x2*)(p + 256 * j + 4 * lane) = o; }
}
__device__ __forceinline__ void ada_ln(f32x4 (&v)[4], const float* sh, const float* sc, int lane) {
    float mean, rstd; ln_stats(v, mean, rstd);
    f32x4 a[4], b[4]; load_row(sc, lane, a); load_row(sh, lane, b);
#pragma unroll
    for (int j = 0; j < 4; ++j) v[j] = (v[j] - mean) * rstd * (1.f + a[j]) + b[j];
}
__device__ __forceinline__ void deepnorm(f32x4 (&x)[4], const f32x4 (&y)[4], const float* g, const float* lg, const float* lb, int lane) {
    f32x4 a[4]; load_row(g, lane, a);
#pragma unroll
    for (int j = 0; j < 4; ++j) x[j] = ALPHA * x[j] + (1.f + a[j]) * y[j];
    float mean, rstd; ln_stats(x, mean, rstd);
    f32x4 b[4]; load_row(lg, lane, a); load_row(lb, lane, b);
#pragma unroll
    for (int j = 0; j < 4; ++j) x[j] = (x[j] - mean) * rstd * a[j] + b[j];
}

struct RowIn2 { f32x4 x[4]; u32x2 xb[4]; u32x2 y[4][4]; };
template <int MODE> __device__ __forceinline__ void row_load(const Frame& F, int row, int lane, RowIn2& r) {
    if (MODE == 0) { load_row(F.in[0] + (size_t)row * D, lane, r.x); return; }
#pragma unroll
    for (int j = 0; j < 4; ++j) r.xb[j] = *(const u32x2*)((const bf16*)(F.ws + WS_XB) + (size_t)row * D + 256 * j + 4 * lane);
    const bf16* yk = (const bf16*)(F.ws + WS_YK) + (size_t)row * 4 * D + 4 * lane;
#pragma unroll
    for (int k = 0; k < 4; ++k)
#pragma unroll
        for (int j = 0; j < 4; ++j) r.y[k][j] = *(const u32x2*)(yk + k * D + 256 * j);
}
__device__ __forceinline__ f32x4 bf4(u32x2 q) { return (f32x4){__uint_as_float(q.x << 16), __uint_as_float(q.x & 0xffff0000u), __uint_as_float(q.y << 16), __uint_as_float(q.y & 0xffff0000u)}; }
template <int MODE> __device__ __forceinline__ void phase_row(const Frame& F, int l) {
    const int gw = F.bid * NWAVES + F.wave, NGW = F.G * NWAVES, lane = F.lane;
    const float* MOD = (const float*)(F.ws + WS_MOD);
    bf16* H = (bf16*)(F.ws + WS_H);
    RowIn2 cur, nxt;
    if (gw < T) row_load<MODE>(F, gw, lane, cur);
    for (int row = gw; row < T; row += NGW) {
        const int b = row >> 11;
        const float* modp = MOD + ((size_t)l * 8 + b) * 6144;
        if (row + NGW < T) row_load<MODE>(F, row + NGW, lane, nxt);
        f32x4 x[4];
#pragma unroll
        for (int j = 0; j < 4; ++j) x[j] = MODE == 0 ? cur.x[j] : bf4(cur.xb[j]);
        if (MODE == 0) {
            ada_ln(x, modp, modp + 1024, lane);
            store_row_bf16(H + (size_t)row * D, lane, x);
        } else {
            f32x4 y[4];
#pragma unroll
            for (int j = 0; j < 4; ++j) y[j] = (bf4(cur.y[0][j]) + bf4(cur.y[1][j])) + (bf4(cur.y[2][j]) + bf4(cur.y[3][j]));
            deepnorm(x, y, modp + 5 * 1024, F.in[12] + (l * 2 + 1) * D, F.in[13] + (l * 2 + 1) * D, lane);
            if (l + 1 == DEPTH) store_row(((float*)F.out) + (size_t)row * D, lane, x);
            else {
                store_row_bf16((bf16*)(F.ws + WS_XB) + (size_t)row * D, lane, x);
                const float* modn = MOD + ((size_t)(l + 1) * 8 + b) * 6144;
                ada_ln(x, modn, modn + 1024, lane);
                store_row_bf16(H + (size_t)row * D, lane, x);
            }
        }
        if (row + NGW < T) {
#pragma unroll
            for (int j = 0; j < 4; ++j) { if (MODE == 0) cur.x[j] = nxt.x[j]; else cur.xb[j] = nxt.xb[j];
#pragma unroll
                for (int k = 0; k < 4; ++k) cur.y[k][j] = nxt.y[k][j]; }
        }
    }
}

__device__ __forceinline__ void ada_ln_r(f32x4 (&v)[4], const f32x4 (&sc1)[4], const f32x4 (&sh)[4]) {
    float mean, rstd; ln_stats(v, mean, rstd);
#pragma unroll
    for (int j = 0; j < 4; ++j) v[j] = (v[j] - mean) * rstd * sc1[j] + sh[j];
}
__device__ __forceinline__ void deepnorm_r(f32x4 (&x)[4], const f32x4 (&y)[4], const f32x4 (&g1)[4], const f32x4 (&lg)[4], const f32x4 (&lb)[4]) {
#pragma unroll
    for (int j = 0; j < 4; ++j) x[j] = ALPHA * x[j] + g1[j] * y[j];
    float mean, rstd; ln_stats(x, mean, rstd);
#pragma unroll
    for (int j = 0; j < 4; ++j) x[j] = (x[j] - mean) * rstd * lg[j] + lb[j];
}
__device__ __forceinline__ void phase_row2(const Frame& F, int l) {
    const int lane = F.lane;
    const float* MOD = (const float*)(F.ws + WS_MOD);
    bf16* H = (bf16*)(F.ws + WS_H); bf16* XB = (bf16*)(F.ws + WS_XB);
    for (int chunk = F.bid; chunk < T / 64; chunk += F.G) {
        const int row0 = chunk * 64 + F.wave * 8, b = row0 >> 11;
        const float* modp = MOD + ((size_t)l * 8 + b) * 6144;
        f32x4 g1[4], lg[4], lb[4], sc1[4], sh[4];
        load_row(modp + 5 * 1024, lane, g1); load_row(F.in[12] + (l * 2 + 1) * D, lane, lg); load_row(F.in[13] + (l * 2 + 1) * D, lane, lb);
#pragma unroll
        for (int j = 0; j < 4; ++j) g1[j] = g1[j] + 1.f;
        if (l + 1 < DEPTH) { const float* modn = MOD + ((size_t)(l + 1) * 8 + b) * 6144; load_row(modn, lane, sh); load_row(modn + 1024, lane, sc1);
#pragma unroll
            for (int j = 0; j < 4; ++j) sc1[j] = sc1[j] + 1.f; }
        else {
#pragma unroll
            for (int j = 0; j < 4; ++j) { sh[j] = (f32x4){0.f, 0.f, 0.f, 0.f}; sc1[j] = sh[j]; } }
        u32x2 cxb[4], nxb[4], cy[4][4], ny[4][4];
        { const bf16* yk = (const bf16*)(F.ws + WS_YK) + (size_t)row0 * 4 * D + 4 * lane;
#pragma unroll
          for (int j = 0; j < 4; ++j) { cxb[j] = *(const u32x2*)(XB + (size_t)row0 * D + 256 * j + 4 * lane);
#pragma unroll
              for (int k = 0; k < 4; ++k) cy[k][j] = *(const u32x2*)(yk + k * D + 256 * j); } }
        for (int i = 0; i < 8; ++i) {
            const int row = row0 + i;
            if (i + 1 < 8) { const bf16* yk = (const bf16*)(F.ws + WS_YK) + (size_t)(row + 1) * 4 * D + 4 * lane;
#pragma unroll
                for (int j = 0; j < 4; ++j) { nxb[j] = *(const u32x2*)(XB + (size_t)(row + 1) * D + 256 * j + 4 * lane);
#pragma unroll
                    for (int k = 0; k < 4; ++k) ny[k][j] = *(const u32x2*)(yk + k * D + 256 * j); } }
            f32x4 x[4], y[4];
#pragma unroll
            for (int j = 0; j < 4; ++j) { x[j] = bf4(cxb[j]); y[j] = (bf4(cy[0][j]) + bf4(cy[1][j])) + (bf4(cy[2][j]) + bf4(cy[3][j])); }
            deepnorm_r(x, y, g1, lg, lb);
            if (l + 1 == DEPTH) store_row(((float*)F.out) + (size_t)row * D, lane, x);
            else {
                store_row_bf16(XB + (size_t)row * D, lane, x);
                ada_ln_r(x, sc1, sh);
                store_row_bf16(H + (size_t)row * D, lane, x);
            }
#pragma unroll
            for (int j = 0; j < 4; ++j) { cxb[j] = nxb[j];
#pragma unroll
                for (int k = 0; k < 4; ++k) cy[k][j] = ny[k][j]; }
        }
    }
}
__device__ __forceinline__ void phase_row1(const Frame& F, int l) {
    const int lane = F.lane, w = F.wave;
    const float* MOD = (const float*)(F.ws + WS_MOD);
    bf16* H = (bf16*)(F.ws + WS_H);
    float* H32 = (float*)(F.ws + WS_PROJ);
    LAS float* lg = (LAS float*)F.lds;
    volatile LAS int* lc = (volatile LAS int*)(F.lds + 16384);
    for (int chunk = F.bid; chunk < T / 64; chunk += F.G) {
        __syncthreads();
        if (F.tid < 64) lc[F.tid] = 0;
        const bf16* XB = (const bf16*)(F.ws + WS_XB);
        f32x4 g1[4], vlg[4], vlb[4], sc1[4], sh[4];
        { const float* modp = MOD + ((size_t)l * 8 + ((chunk * 64) >> 11)) * 6144;
          load_row(modp + 2048, lane, g1); load_row(F.in[12] + (l * 2 + 0) * D, lane, vlg); load_row(F.in[13] + (l * 2 + 0) * D, lane, vlb); load_row(modp + 3 * 1024, lane, sh); load_row(modp + 4 * 1024, lane, sc1);
#pragma unroll
          for (int j = 0; j < 4; ++j) { g1[j] = g1[j] + 1.f; sc1[j] = sc1[j] + 1.f; } }
        f32x4 cx[4], nx[4]; u32x2 cy[4], ny[4];
        { const int row = chunk * 64 + w * 8; if (l == 0) load_row(F.in[0] + (size_t)row * D, lane, cx); else load_row_bf16(XB + (size_t)row * D, lane, cx);
#pragma unroll
          for (int j = 0; j < 4; ++j) cy[j] = *(const u32x2*)((const bf16*)(F.ws + WS_MIX) + (size_t)row * D + 256 * j + 4 * lane); }
        for (int i = 0; i < 8; ++i) {
            const int row = chunk * 64 + w * 8 + i, b = row >> 11;
            const float* modp = MOD + ((size_t)l * 8 + b) * 6144;
            if (i + 1 < 8) { if (l == 0) load_row(F.in[0] + (size_t)(row + 1) * D, lane, nx); else load_row_bf16(XB + (size_t)(row + 1) * D, lane, nx);
#pragma unroll
                for (int j = 0; j < 4; ++j) ny[j] = *(const u32x2*)((const bf16*)(F.ws + WS_MIX) + (size_t)(row + 1) * D + 256 * j + 4 * lane); }
            f32x4 x[4], y[4];
#pragma unroll
            for (int j = 0; j < 4; ++j) { x[j] = cx[j]; y[j] = bf4(cy[j]); }
            deepnorm_r(x, y, g1, vlg, vlb);
            store_row_bf16((bf16*)(F.ws + WS_XB) + (size_t)row * D, lane, x);
            ada_ln_r(x, sc1, sh);
            store_row(H32 + (size_t)row * D, lane, x);
            {
                float am = 0.f;
#pragma unroll
                for (int j = 0; j < 4; ++j) am = fmaxf(am, fmaxf(fmaxf(fabsf(x[j].x), fabsf(x[j].y)), fmaxf(fabsf(x[j].z), fabsf(x[j].w))));
                am = fmaxf(wmaxf(am), 1e-20f);
                const float qs = 224.f / am;
                unsigned char* hq = (unsigned char*)(F.ws + WS_HQ) + (size_t)row * D;
#pragma unroll
                for (int j = 0; j < 4; ++j) *(unsigned*)(hq + 256 * j + 4 * lane) = pk4_fp8(x[j] * qs);
                if (lane == 0) ((float*)(F.ws + WS_HS))[row] = am * (1.f / 224.f);
            }
#pragma unroll
            for (int j = 0; j < 4; ++j) { cx[j] = nx[j]; cy[j] = ny[j]; }
        }
        asm volatile("s_waitcnt vmcnt(0)" ::: "memory");
        __syncthreads();
        {
            const int fr = lane & 15, fq = lane >> 4, tile = w >> 1, nt = w & 1;
            const float* wp = (const float*)(F.ws + WS_RWT) + ((size_t)l * NE + 16 * nt + fr) * D + 256 * fq;
            const float* hp = H32 + (size_t)(chunk * 64 + 16 * tile + fr) * D + 256 * fq;
            f32x4 c = {0.f, 0.f, 0.f, 0.f};
#pragma unroll 16
            for (int s4 = 0; s4 < 256; s4 += 4) { const f32x4 a = *(const f32x4*)(wp + s4), bq = *(const f32x4*)(hp + s4);
                c = __builtin_amdgcn_mfma_f32_16x16x4f32(a.x, bq.x, c, 0, 0, 0); c = __builtin_amdgcn_mfma_f32_16x16x4f32(a.y, bq.y, c, 0, 0, 0);
                c = __builtin_amdgcn_mfma_f32_16x16x4f32(a.z, bq.z, c, 0, 0, 0); c = __builtin_amdgcn_mfma_f32_16x16x4f32(a.w, bq.w, c, 0, 0, 0); }
#pragma unroll
            for (int j = 0; j < 4; ++j) { const int e = 16 * nt + 4 * fq + j; lg[(16 * tile + fr) * 33 + e] = c[j] + F.in[15][l * NE + e]; }
        }
        __syncthreads();
        if (w == 0) {
            const int row = chunk * 64 + lane;
            float v[32];
#pragma unroll
            for (int e = 0; e < 32; ++e) v[e] = lg[lane * 33 + e];
            float tv[4]; int ti[4];
#pragma unroll
            for (int r = 0; r < 4; ++r) { float bv = v[0]; int bi = 0;
#pragma unroll
                for (int e = 1; e < 32; ++e) { const bool tk = v[e] > bv; bv = tk ? v[e] : bv; bi = tk ? e : bi; }
                tv[r] = bv; ti[r] = bi;
#pragma unroll
                for (int e = 0; e < 32; ++e) v[e] = (e == bi) ? -INFINITY : v[e]; }
            float ev[4], es = 0.f;
#pragma unroll
            for (int r = 0; r < 4; ++r) { ev[r] = expf(tv[r] - tv[0]); es += ev[r]; }
            const float rowscale = ((const float*)(F.ws + WS_HS))[row];
            int lp[4];
#pragma unroll
            for (int r = 0; r < 4; ++r) lp[r] = __hip_atomic_fetch_add((LAS int*)(F.lds + 16384) + ti[r], 1, __ATOMIC_RELAXED, __HIP_MEMORY_SCOPE_WORKGROUP);
            LDS_WAIT();
            int base = 0;
            if (lane < 32) { const int c = lc[lane]; unsigned* cnt = (unsigned*)(F.ws + WS_CTL) + CW_CNT + l * NE; base = c > 0 ? (int)atomicAdd(cnt + lane, (unsigned)c) : 0; }
#pragma unroll
            for (int r = 0; r < 4; ++r) { const int bs = __shfl(base, ti[r]);
                ((int*)(F.ws + WS_LIST))[(size_t)ti[r] * T + bs + lp[r]] = row * 4 + r;
                ((float*)(F.ws + WS_LHS))[(size_t)ti[r] * T + bs + lp[r]] = rowscale;
                ((float*)(F.ws + WS_LGW))[(size_t)ti[r] * T + bs + lp[r]] = ev[r] / es;
                ((float*)(F.ws + WS_GATEW))[row * 4 + r] = ev[r] / es; }
        }
    }
}

struct GemmCtx { int wr, wc, fr, fq; };
template <class RowFn, class Epi>
__device__ __forceinline__ void gemm_unit(const Frame& F, const bf16* A, const RowFn& arow, const bf16* Bt, const Epi& E, const int nk = 32, const int ldb = D) {
    const int tid = F.tid, lane = F.lane, wid = F.wave;
    GemmCtx cx; cx.wr = wid >> 1; cx.wc = wid & 1; cx.fr = lane & 15; cx.fq = lane >> 4;
    const int sr = tid >> 2, sc = (tid & 3) * 8;
    const bf16* srcA0 = A + (size_t)arow(sr) * D + sc;
    const bf16* srcA1 = A + (size_t)arow(sr + 128) * D + sc;
    const bf16* srcB = Bt + (size_t)sr * ldb + sc;
    LAS unsigned char* lds = F.lds;
    f32x4 acc[4][4];
#pragma unroll
    for (int m = 0; m < 4; ++m)
#pragma unroll
        for (int n = 0; n < 4; ++n) acc[m][n] = (f32x4){0.f, 0.f, 0.f, 0.f};
#define STAGE(t, buf) do { \
        __builtin_amdgcn_global_load_lds((const unsigned*)(srcA0 + (t) * 32), (LAS unsigned*)(lds + (buf) * 24576 + tid * 16), 16, 0, 0); \
        __builtin_amdgcn_global_load_lds((const unsigned*)(srcA1 + (t) * 32), (LAS unsigned*)(lds + (buf) * 24576 + 8192 + tid * 16), 16, 0, 0); \
        __builtin_amdgcn_global_load_lds((const unsigned*)(srcB + (t) * 32), (LAS unsigned*)(lds + (buf) * 24576 + 16384 + tid * 16), 16, 0, 0); } while (0)
    const int aoff = (cx.wr * 64 + cx.fr) * 64 + cx.fq * 16, boff = (cx.wc * 64 + cx.fr) * 64 + cx.fq * 16;
    __syncthreads();
    STAGE(0, 0); if (nk > 1) STAGE(1, 1); if (nk > 2) STAGE(2, 2);
    for (int t = 0; t < nk; ++t) {
        if (t + 2 < nk) asm volatile("s_waitcnt vmcnt(6)" ::: "memory"); else if (t + 1 < nk) asm volatile("s_waitcnt vmcnt(3)" ::: "memory"); else asm volatile("s_waitcnt vmcnt(0)" ::: "memory");
        __syncthreads();
        if (t + 3 < nk) STAGE(t + 3, (t + 3) & 3);
        const LAS unsigned char* ba = lds + (t & 3) * 24576 + aoff;
        const LAS unsigned char* bb = lds + (t & 3) * 24576 + 16384 + boff;
        bf16x8 a[4], b[4];
#pragma unroll
        for (int m = 0; m < 4; ++m) a[m] = *(const LAS bf16x8*)(ba + m * 1024);
#pragma unroll
        for (int n = 0; n < 4; ++n) b[n] = *(const LAS bf16x8*)(bb + n * 1024);
#pragma unroll
        for (int m = 0; m < 4; ++m)
#pragma unroll
            for (int n = 0; n < 4; ++n) acc[m][n] = __builtin_amdgcn_mfma_f32_16x16x32_bf16(b[n], a[m], acc[m][n], 0, 0, 0);
    }
#undef STAGE
    E(acc, cx);
}


namespace pg8 {
constexpr int BM = 256, BK = 64, HALF = 128, HTB = HALF * BK * 2, NXCD = 8, WGM = 8, KK = 1024, NT = KK / BK;
constexpr int NA_OFF = 131072 + 1024;
constexpr int SB_SIZE = 3072;
__device__ __forceinline__ int lds_byte(int r, int c) { const int st = (r >> 4) * 2 + (c >> 5), rr = r & 15, cc = c & 31, ob = rr * 64 + cc * 2; return st * 1024 + (ob ^ (((ob >> 9) & 1) << 5)); }
__device__ __forceinline__ void stage_rc(int b, int& R, int& C) { const int st = b / 1024, sb = b % 1024, swz = sb ^ (((sb >> 9) & 1) << 5); R = (st >> 1) * 16 + swz / 64; C = (st & 1) * 32 + (swz % 64) / 2; }
struct Unit { int pm, pn, e, nvalid, lrow0; };
__device__ __forceinline__ int xcd_remap(int L, int nwg) { const int q = nwg / NXCD, r = nwg % NXCD, xcd = L % NXCD, off = L / NXCD; return (xcd < r ? xcd * (q + 1) : r * (q + 1) + (xcd - r) * q) + off; }
struct StaticOrder {
    int nM, nN, nwg, G, c;
    __device__ __forceinline__ void init(int M, int N, int G_, int c_) { nM = M / BM; nN = N / BM; nwg = nM * nN; G = G_; c = c_; }
    __device__ __forceinline__ bool next(int i, Unit& u) const {
        const int L = i * G + c; if (L >= nwg) return false;
        const int wgid = xcd_remap(L, nwg);
        const int nig = WGM * nN, gid = wgid / nig, fm = gid * WGM, gsz = (nM - fm) < WGM ? (nM - fm) : WGM;
        u.pm = fm + ((wgid % nig) % gsz); u.pn = (wgid % nig) / gsz; u.e = 0; u.nvalid = 256; u.lrow0 = 0; return true;
    }
};
struct MoeOrder {
    volatile LAS int* M; int NCT, nwg, G, c;
    __device__ __forceinline__ bool next(int i, Unit& u) const {
        const int L = i * G + c; if (L >= nwg) return false;
        const int wgid = xcd_remap(L, nwg);
        const int rtg = wgid / NCT; u.pn = wgid % NCT;
        int e = 0;
#pragma unroll 1
        for (int step = 16; step >= 1; step >>= 1) e = (rtg >= M[48 + e + step]) ? e + step : e;
        const int rt = rtg - M[48 + e];
        u.pm = rtg; u.e = e; u.lrow0 = rt * 256; u.nvalid = min(256, M[16 + e] - rt * 256); return true;
    }
};
struct ADense { __device__ __forceinline__ int operator()(const Unit& u, int rl) const { return u.pm * 256 + rl; } };
struct AGather { const int* list; __device__ __forceinline__ int operator()(const Unit& u, int rl) const { return list[(size_t)u.e * T + u.lrow0 + min(rl, u.nvalid - 1)] >> 2; } };
struct BDense { const bf16* Bt; __device__ __forceinline__ const char* operator()(const Unit& u) const { return (const char*)(Bt + (size_t)u.pn * 256 * KK); } };
struct BExpert8 { const unsigned char* Bt; size_t estride; __device__ __forceinline__ const char* operator()(const Unit& u) const { return (const char*)(Bt + (size_t)u.e * estride + (size_t)u.pn * 256 * KK); } };
typedef int i32x8 __attribute__((ext_vector_type(8)));
typedef int i32x4_ __attribute__((ext_vector_type(4)));

template <bool FP8, class Epi, class Sched, class ARow, class BBase>
__device__ __forceinline__ void gemm_phase(LAS unsigned char* lds, const void* Abase, const ARow& AR, const BBase& BB, const Sched& S, const Epi& E, int tid) {
    const int wid = __builtin_amdgcn_readfirstlane(tid >> 6), lane = tid & 63, wr = wid >> 2, wc = wid & 3, fr = lane & 15, fq = lane >> 4;
    constexpr int RB = FP8 ? KK : KK * 2, nt = RB / 128;
    unsigned voffB[2];
#pragma unroll
    for (int i = 0; i < 2; ++i) { int R, C; stage_rc(tid * 16 + i * 8192, R, C); voffB[i] = (unsigned)(R * RB + C * 2); }
    constexpr size_t kstep = (size_t)(BK * 2), hstep = (size_t)HALF * RB;
    const unsigned ldsw = (unsigned)wid * 1024u;
    const int aoff = lds_byte(wr * 64 + fr, fq * 8), boff = lds_byte(wc * 32 + fr, fq * 8);
    const char* Ab = (const char*)Abase;
#define PG8_SA(b, h) (((b) * 2 + (h)) * HTB)
#define PG8_SB(b, h) ((4 + (b) * 2 + (h)) * HTB)
#define PG8_STAGEB(bufoff, gbase) do { _Pragma("unroll") for (int _i = 0; _i < 2; ++_i) \
        __builtin_amdgcn_global_load_lds((const unsigned*)((gbase) + voffB[_i]), (LAS unsigned*)(lds + (bufoff) + ldsw + _i * 8192), 16, 0, 0); } while (0)
#define PG8_STAGEA(bufoff, offs, h, kb) do { _Pragma("unroll") for (int _i = 0; _i < 2; ++_i) \
        __builtin_amdgcn_global_load_lds((const unsigned*)(Ab + (size_t)((offs)[h][_i] + (unsigned)(kb))), (LAS unsigned*)(lds + (bufoff) + ldsw + _i * 8192), 16, 0, 0); } while (0)
#define PG8_LDA(dst, b, h) do { _Pragma("unroll") for (int m = 0; m < 4; ++m) _Pragma("unroll") for (int k = 0; k < 2; ++k) dst[m][k] = *(const LAS bf16x8*)(lds + PG8_SA(b, h) + aoff + m * 2048 + k * 1024); } while (0)
#define PG8_LDB(dst, b, h) do { _Pragma("unroll") for (int n = 0; n < 2; ++n) _Pragma("unroll") for (int k = 0; k < 2; ++k) dst[n][k] = *(const LAS bf16x8*)(lds + PG8_SB(b, h) + boff + n * 2048 + k * 1024); } while (0)
#define PG8_CAT(x) __builtin_shufflevector(__builtin_bit_cast(i32x4_, (x)[0]), __builtin_bit_cast(i32x4_, (x)[1]), 0, 1, 2, 3, 4, 5, 6, 7)
#define PG8_MMA(ai, bj, At, Bt) do { __builtin_amdgcn_s_setprio(1); _Pragma("unroll") for (int m = 0; m < 4; ++m) _Pragma("unroll") for (int n = 0; n < 2; ++n) { \
        if constexpr (FP8) acc[ai][bj][m][n] = __builtin_amdgcn_mfma_scale_f32_16x16x128_f8f6f4(PG8_CAT(Bt[n]), PG8_CAT(At[m]), acc[ai][bj][m][n], 0, 0, 0, 0x7F7F7F7F, 0, 0x7F7F7F7F); \
        else { _Pragma("unroll") for (int k = 0; k < 2; ++k) acc[ai][bj][m][n] = __builtin_amdgcn_mfma_f32_16x16x32_bf16(Bt[n][k], At[m][k], acc[ai][bj][m][n], 0, 0, 0); } } \
        __builtin_amdgcn_s_setprio(0); } while (0)
#define PG8_WAIT_V(n) asm volatile("s_waitcnt vmcnt(" #n ")" ::: "memory")
#define PG8_WAIT_L(n) asm volatile("s_waitcnt lgkmcnt(" #n ")" ::: "memory")
#define PG8_BAR __builtin_amdgcn_s_barrier()
#define PG8_SCHED __builtin_amdgcn_sched_barrier(0)
#define PG8_AOFFS(dst, u) do { int _t = tid; asm volatile("" : "+v"(_t)); _Pragma("unroll") for (int _i = 0; _i < 2; ++_i) { int _R, _C; stage_rc(_t * 16 + _i * 8192, _R, _C); \
        _Pragma("unroll") for (int _h = 0; _h < 2; ++_h) dst[_h][_i] = (unsigned)AR((u), _h * HALF + _R) * (unsigned)RB + (unsigned)_C * 2u; } } while (0)
    Unit cur, nxt; int ui = 0;
    if (!S.next(0, cur)) return;
    f32x4 acc[2][2][4][2];
#pragma unroll
    for (int a = 0; a < 2; ++a)
#pragma unroll
        for (int b = 0; b < 2; ++b)
#pragma unroll
            for (int m = 0; m < 4; ++m)
#pragma unroll
                for (int n = 0; n < 2; ++n) acc[a][b][m][n] = (f32x4){0.f, 0.f, 0.f, 0.f};
    bf16x8 At[4][2], B0[2][2], B1[2][2];
    unsigned cA[2][2];
    PG8_AOFFS(cA, cur);
    const char* cB = BB(cur);
    PG8_STAGEB(PG8_SB(0, 0), cB); PG8_STAGEB(PG8_SB(0, 1), cB + hstep); PG8_STAGEA(PG8_SA(0, 0), cA, 0, 0); PG8_STAGEA(PG8_SA(0, 1), cA, 1, 0);
    PG8_STAGEB(PG8_SB(1, 0), cB + kstep); PG8_STAGEA(PG8_SA(1, 0), cA, 0, kstep); PG8_STAGEB(PG8_SB(1, 1), cB + hstep + kstep);
    if (wr == 1) PG8_BAR;
    PG8_WAIT_V(8); PG8_BAR;
    PG8_WAIT_V(6); PG8_BAR;
    for (;;) {
        const bool has_next = S.next(ui + 1, nxt);
        const char* nB = cB;
        {
            unsigned nA[2][2];
            if (has_next) { PG8_AOFFS(nA, nxt); nB = BB(nxt); }
            else {
#pragma unroll
                for (int _h = 0; _h < 2; ++_h)
#pragma unroll
                    for (int _i = 0; _i < 2; ++_i) nA[_h][_i] = cA[_h][_i];
            }
            *(LAS u32x4*)(lds + NA_OFF + tid * 16) = (u32x4){nA[0][0], nA[0][1], nA[1][0], nA[1][1]};
        }
        if constexpr (Epi::PREFETCH) E.prefetch(lds + (ui & 1) * SB_SIZE, cur, tid);
        for (int t = 0; t < nt; t += 2) {
            const bool last = (t == nt - 2);
            const unsigned k1 = (unsigned)((t + 1) * kstep), kb2 = last ? 0u : (unsigned)((t + 2) * kstep);
            const char* b2 = last ? nB : cB + (size_t)(t + 2) * kstep; const char* b3 = b2 + kstep;
            PG8_LDB(B0, 0, 0); PG8_LDB(B1, 0, 1); PG8_SCHED; PG8_LDA(At, 0, 0); PG8_STAGEA(PG8_SA(1, 1), cA, 1, k1);
            if (last) { const u32x4 q = *(const LAS u32x4*)(lds + NA_OFF + tid * 16); cA[0][0] = q.x; cA[0][1] = q.y; cA[1][0] = q.z; cA[1][1] = q.w; }
            PG8_WAIT_V(8); PG8_WAIT_L(0); PG8_BAR; PG8_MMA(0, 0, At, B0); PG8_MMA(0, 1, At, B1); PG8_BAR; PG8_SCHED;
            PG8_LDA(At, 0, 1); PG8_STAGEB(PG8_SB(0, 0), b2); PG8_STAGEB(PG8_SB(0, 1), b2 + hstep); PG8_STAGEA(PG8_SA(0, 0), cA, 0, kb2);
            PG8_WAIT_V(8); PG8_WAIT_L(0); PG8_BAR; PG8_MMA(1, 0, At, B0); PG8_MMA(1, 1, At, B1); PG8_BAR; PG8_SCHED;
            PG8_LDB(B0, 1, 0); PG8_LDB(B1, 1, 1); PG8_SCHED; PG8_LDA(At, 1, 0); PG8_STAGEA(PG8_SA(0, 1), cA, 1, kb2);
            PG8_WAIT_V(8); PG8_WAIT_L(0); PG8_BAR; PG8_MMA(0, 0, At, B0); PG8_MMA(0, 1, At, B1); PG8_BAR; PG8_SCHED;
            PG8_LDA(At, 1, 1); PG8_STAGEB(PG8_SB(1, 0), b3); PG8_STAGEB(PG8_SB(1, 1), b3 + hstep); PG8_STAGEA(PG8_SA(1, 0), cA, 0, kb2 + (unsigned)kstep);
            PG8_WAIT_V(8); PG8_WAIT_L(0); PG8_BAR; PG8_MMA(1, 0, At, B0); PG8_MMA(1, 1, At, B1); PG8_BAR; PG8_SCHED;
        }
        if (wr == 0) PG8_BAR;
        { int efr = fr, efq = fq; asm volatile("" : "+v"(efr), "+v"(efq));
          if constexpr (Epi::PREFETCH) E(acc, cur, wr, wc, efr, efq, lds + (ui & 1) * SB_SIZE); else E(acc, cur, wr, wc, efr, efq); }
        if (!has_next) break;
#pragma unroll
        for (int a = 0; a < 2; ++a)
#pragma unroll
            for (int b = 0; b < 2; ++b)
#pragma unroll
                for (int m = 0; m < 4; ++m)
#pragma unroll
                    for (int n = 0; n < 2; ++n) acc[a][b][m][n] = (f32x4){0.f, 0.f, 0.f, 0.f};
        cur = nxt; cB = nB; ++ui;
        if (wr == 1) PG8_BAR;
    }
    PG8_WAIT_V(0);
    PG8_BAR;
#undef PG8_SA
#undef PG8_SB
#undef PG8_STAGEA
#undef PG8_STAGEB
#undef PG8_LDA
#undef PG8_LDB
#undef PG8_MMA
#undef PG8_CAT
#undef PG8_WAIT_V
#undef PG8_WAIT_L
#undef PG8_BAR
#undef PG8_SCHED
#undef PG8_AOFFS
}
}

struct RowIdent { int row0; __device__ __forceinline__ int operator()(int r) const { return row0 + r; } };
struct RowList { const int* list; int nvalid; __device__ __forceinline__ int operator()(int r) const { return r < nvalid ? (list[r] >> 2) : 0; } };

struct EpiF32 {
    float* C; int ld, row0, col0;
    __device__ __forceinline__ void operator()(const f32x4 (&acc)[4][4], const GemmCtx& cx) const {
#pragma unroll
        for (int m = 0; m < 4; ++m) { float* rp = C + (size_t)(row0 + cx.wr * 64 + m * 16 + cx.fr) * ld + col0 + cx.wc * 64 + cx.fq * 4;
#pragma unroll
            for (int n = 0; n < 4; ++n) *(f32x4*)(rp + n * 16) = acc[m][n]; }
    }
};

__device__ __forceinline__ void st4bf(bf16* dst, f32x4 v) { u32x2 o; o.x = cvt_pk_bf16(v.x, v.y); o.y = cvt_pk_bf16(v.z, v.w); *(u32x2*)dst = o; }
__device__ __forceinline__ void st8bf(bf16* dst, f32x4 a, f32x4 b) { u32x4 o; o.x = cvt_pk_bf16(a.x, a.y); o.y = cvt_pk_bf16(a.z, a.w); o.z = cvt_pk_bf16(b.x, b.y); o.w = cvt_pk_bf16(b.z, b.w); *(u32x4*)dst = o; }
__device__ __forceinline__ float bf2f(unsigned short x) { return __uint_as_float(((unsigned)x) << 16); }
struct EpiIn {
    unsigned char* ws; int row0, col0;
    __device__ __forceinline__ void operator()(const f32x4 (&acc)[4][4], const GemmCtx& cx) const {
        if (KEEP_PROJ) { EpiF32 e{(float*)(ws + WS_PROJ), PLD, row0, col0}; e(acc, cx); }
        const int G = (col0 + cx.wc * 64) >> 6;
        if (G >= 49) return;
        const int dq = cx.fq * 4;
        const bool rope = (G < 8) || (G >= 28 && G < 36) || G == 40 || G == 41 || G == 44 || G == 45;
        do_row(acc[0][0], acc[0][1], acc[0][2], acc[0][3], row0 + cx.wr * 64 + 0 * 16 + cx.fr, G, dq, rope);
        do_row(acc[1][0], acc[1][1], acc[1][2], acc[1][3], row0 + cx.wr * 64 + 1 * 16 + cx.fr, G, dq, rope);
        do_row(acc[2][0], acc[2][1], acc[2][2], acc[2][3], row0 + cx.wr * 64 + 2 * 16 + cx.fr, G, dq, rope);
        do_row(acc[3][0], acc[3][1], acc[3][2], acc[3][3], row0 + cx.wr * 64 + 3 * 16 + cx.fr, G, dq, rope);
    }
    __device__ __forceinline__ void do_row(f32x4 v0, f32x4 v1, f32x4 v2, f32x4 v3, const int row, int G, int dq, bool rope) const {
        f32x4 c0 = {0.f, 0.f, 0.f, 0.f}, c1 = c0, s0 = c0, s1 = c0;
        if (rope) { const float* cp = (const float*)(ws + WS_ROPEC) + (size_t)row * 32 + dq; const float* sp = (const float*)(ws + WS_ROPES) + (size_t)row * 32 + dq;
            c0 = *(const f32x4*)cp; c1 = *(const f32x4*)(cp + 16); s0 = *(const f32x4*)sp; s1 = *(const f32x4*)(sp + 16); }
        do_row_r(v0, v1, v2, v3, row, G, dq, rope, c0, c1, s0, s1);
    }
    __device__ __forceinline__ void do_row_r(f32x4 v0, f32x4 v1, f32x4 v2, f32x4 v3, const int row, int G, int dq, bool rope, f32x4 c0, f32x4 c1, f32x4 s0, f32x4 s1) const {
        {
            const int b = row >> 11, t = row & (S - 1);
            f32x4 v[4] = {v0, v1, v2, v3};
            if (G >= 28 && G < 36) { bf16* dst = (bf16*)(ws + WS_NQU) + (((size_t)b * 8 + (G - 28)) * S + t) * 64 + dq;
#pragma unroll
                for (int n = 0; n < 4; ++n) { v[n] = v[n] * NSA_QS; st4bf(dst + n * 16, v[n]); } }
            if (rope) {
                { const f32x4 lo = v[0], hi = v[2]; v[0] = lo * c0 - hi * s0; v[2] = hi * c0 + lo * s0; }
                { const f32x4 lo = v[1], hi = v[3]; v[1] = lo * c1 - hi * s1; v[3] = hi * c1 + lo * s1; }
            }
            bf16* dst = nullptr; bf16* tdst = nullptr;
            if (G < 4) dst = (bf16*)(ws + WS_PRQ) + (((size_t)b * 4 + G) * S + t) * 64;
            else if (G < 8) { dst = (bf16*)(ws + WS_PRK) + (((size_t)b * 4 + (G - 4)) * S + t) * 64;
#pragma unroll
                for (int n = 0; n < 4; ++n) v[n] = v[n] * 0.125f; }
            else if (G < 12) dst = (bf16*)(ws + WS_PRV) + (((size_t)b * 4 + (G - 8)) * S + t) * 64;
            else if (G < 16) dst = (bf16*)(ws + WS_RG) + (size_t)row * 256 + (G - 12) * 64;
            else if (G < 28) dst = (bf16*)(ws + WS_CV) + (size_t)row * 768 + (G - 16) * 64;
            else if (G < 36) dst = (bf16*)(ws + WS_NQRB) + (((size_t)b * 8 + (G - 28)) * S + t) * 64;
            else if (G < 38) dst = (bf16*)(ws + WS_NKC) + (((size_t)b * 2 + (G - 36)) * S + t) * 64;
            else if (G < 40) dst = (bf16*)(ws + WS_NVC) + (((size_t)b * 2 + (G - 38)) * S + t) * 64;
            else if (G < 42) dst = (bf16*)(ws + WS_NKS) + (((size_t)b * 2 + (G - 40)) * S + t) * 64;
            else if (G < 44) tdst = (bf16*)(ws + WS_NVST) + (((size_t)b * 2 + (G - 42)) * 64) * S + t;
            else if (G < 46) dst = (bf16*)(ws + WS_NKW) + (((size_t)b * 2 + (G - 44)) * S + t) * 64;
            else if (G < 48) tdst = (bf16*)(ws + WS_NVWT) + (((size_t)b * 2 + (G - 46)) * 64) * S + t;
            if (dst) {
#pragma unroll
                for (int n = 0; n < 4; ++n) st4bf(dst + n * 16 + dq, v[n]);
            } else if (tdst) {
#pragma unroll
                for (int n = 0; n < 4; ++n)
#pragma unroll
                    for (int j = 0; j < 4; ++j) tdst[(size_t)(n * 16 + dq + j) * S] = (bf16)(cvt_pk_bf16(v[n][j], v[n][j]) & 0xffffu);
            } else {
                float* ng = (float*)(ws + WS_NG) + (size_t)row * 24;
#pragma unroll
                for (int n = 0; n < 2; ++n)
#pragma unroll
                    for (int j = 0; j < 4; ++j) { const int d = n * 16 + dq + j; if (d < 24) ng[d] = sigmoidf_(v[n][j]); }
            }
        }
    }
};
struct EpiGU {
    bf16* ACT; const float* bias; int pbase, nvalid, ct;
    __device__ __forceinline__ void operator()(const f32x4 (&acc)[4][4], const GemmCtx& cx) const {
#pragma unroll
        for (int m = 0; m < 4; ++m) { const int r = cx.wr * 64 + m * 16 + cx.fr; if (r >= nvalid) continue;
#pragma unroll
            for (int np = 0; np < 2; ++np) {
                const int col = ct * 64 + cx.wc * 32 + np * 16 + cx.fq * 4;
                const f32x4 bg = *(const f32x4*)(bias + col), bu = *(const f32x4*)(bias + 1024 + col);
                const f32x4 g = acc[m][2 * np] + bg, u = acc[m][2 * np + 1] + bu;
                float o[4];
#pragma unroll
                for (int j = 0; j < 4; ++j) { const float gc = fminf(g[j], 7.f), uc = fminf(fmaxf(u[j], -7.f), 7.f); o[j] = (uc + 1.f) * (gc * sigmoidf_(1.702f * gc)); }
                u32x2 w; w.x = cvt_pk_bf16(o[0], o[1]); w.y = cvt_pk_bf16(o[2], o[3]);
                *(u32x2*)(ACT + (size_t)(pbase + r) * FF + col) = w; } }
    }
};
struct EpiDN {
    float* YK; const float* bias; const int* list; const float* gatew; int nvalid, col0;
    __device__ __forceinline__ void operator()(const f32x4 (&acc)[4][4], const GemmCtx& cx) const {
#pragma unroll
        for (int m = 0; m < 4; ++m) { const int r = cx.wr * 64 + m * 16 + cx.fr; if (r >= nvalid) continue;
            const int slot = list[r]; const float w = gatew[slot];
#pragma unroll
            for (int n = 0; n < 4; ++n) { const int col = col0 + cx.wc * 64 + n * 16 + cx.fq * 4;
                const f32x4 bv = *(const f32x4*)(bias + col);
                *(f32x4*)(YK + (size_t)slot * D + col) = (acc[m][n] + bv) * w; } }
    }
};


struct EpiIn2 {
    static constexpr bool PREFETCH = false;
    unsigned char* ws;
    __device__ __forceinline__ void row(f32x4 v0, f32x4 v1, f32x4 v2, f32x4 v3, const int row, int G, int d0, bool rope, f32x4 c0, f32x4 c1, f32x4 s0, f32x4 s1) const {
        const int b = row >> 11, t = row & (S - 1);
        if (G >= 28 && G < 36) { bf16* dst = (bf16*)(ws + WS_NQU) + (((size_t)b * 8 + (G - 28)) * S + t) * 64 + d0;
            v0 = v0 * NSA_QS; v1 = v1 * NSA_QS; v2 = v2 * NSA_QS; v3 = v3 * NSA_QS; st8bf(dst, v0, v1); st8bf(dst + 32, v2, v3); }
        if (rope) {
            { const f32x4 lo = v0, hi = v2; v0 = lo * c0 - hi * s0; v2 = hi * c0 + lo * s0; }
            { const f32x4 lo = v1, hi = v3; v1 = lo * c1 - hi * s1; v3 = hi * c1 + lo * s1; }
        }
        bf16* dst = nullptr; bf16* tdst = nullptr;
        if (G < 4) dst = (bf16*)(ws + WS_PRQ) + (((size_t)b * 4 + G) * S + t) * 64;
        else if (G < 8) { dst = (bf16*)(ws + WS_PRK) + (((size_t)b * 4 + (G - 4)) * S + t) * 64; v0 = v0 * 0.125f; v1 = v1 * 0.125f; v2 = v2 * 0.125f; v3 = v3 * 0.125f; }
        else if (G < 12) dst = (bf16*)(ws + WS_PRV) + (((size_t)b * 4 + (G - 8)) * S + t) * 64;
        else if (G < 16) dst = (bf16*)(ws + WS_RG) + (size_t)row * 256 + (G - 12) * 64;
        else if (G < 28) dst = (bf16*)(ws + WS_CV) + (size_t)row * 768 + (G - 16) * 64;
        else if (G < 36) dst = (bf16*)(ws + WS_NQRB) + (((size_t)b * 8 + (G - 28)) * S + t) * 64;
        else if (G < 38) dst = (bf16*)(ws + WS_NKC) + (((size_t)b * 2 + (G - 36)) * S + t) * 64;
        else if (G < 40) dst = (bf16*)(ws + WS_NVC) + (((size_t)b * 2 + (G - 38)) * S + t) * 64;
        else if (G < 42) dst = (bf16*)(ws + WS_NKS) + (((size_t)b * 2 + (G - 40)) * S + t) * 64;
        else if (G < 44) tdst = (bf16*)(ws + WS_NVST) + (((size_t)b * 2 + (G - 42)) * 64) * S + t;
        else if (G < 46) dst = (bf16*)(ws + WS_NKW) + (((size_t)b * 2 + (G - 44)) * S + t) * 64;
        else tdst = (bf16*)(ws + WS_NVWT) + (((size_t)b * 2 + (G - 46)) * 64) * S + t;
        if (dst) { st8bf(dst + d0, v0, v1); st8bf(dst + 32 + d0, v2, v3); }
        else {
#pragma unroll
            for (int j = 0; j < 4; ++j) {
                tdst[(size_t)(d0 + j) * S] = (bf16)(cvt_pk_bf16(v0[j], v0[j]) & 0xffffu); tdst[(size_t)(d0 + 4 + j) * S] = (bf16)(cvt_pk_bf16(v1[j], v1[j]) & 0xffffu);
                tdst[(size_t)(32 + d0 + j) * S] = (bf16)(cvt_pk_bf16(v2[j], v2[j]) & 0xffffu); tdst[(size_t)(36 + d0 + j) * S] = (bf16)(cvt_pk_bf16(v3[j], v3[j]) & 0xffffu); }
        }
    }
    __device__ __forceinline__ void operator()(const f32x4 (&acc)[2][2][4][2], const pg8::Unit& u, int wr, int wc, int fr, int fq) const {
        const int G = 4 * u.pn + wc, d0 = fq * 8;
        const bool rope = (G < 8) || (G >= 28 && G < 36) || G == 40 || G == 41 || G == 44 || G == 45;
#pragma unroll
        for (int ai = 0; ai < 2; ++ai) {
            const int rb = u.pm * 256 + 128 * ai + 64 * wr + fr;
#pragma unroll
            for (int mp = 0; mp < 2; ++mp) {
                f32x4 c0[2], c1[2], s0[2], s1[2];
#pragma unroll
                for (int m = 0; m < 2; ++m) { c0[m] = (f32x4){0.f, 0.f, 0.f, 0.f}; c1[m] = c0[m]; s0[m] = c0[m]; s1[m] = c0[m]; }
                if (rope) {
#pragma unroll
                    for (int m = 0; m < 2; ++m) { const float* cp = (const float*)(ws + WS_ROPEC) + (size_t)(rb + 16 * (2 * mp + m)) * 32 + d0; const float* sp = (const float*)(ws + WS_ROPES) + (size_t)(rb + 16 * (2 * mp + m)) * 32 + d0;
                        c0[m] = *(const f32x4*)cp; c1[m] = *(const f32x4*)(cp + 4); s0[m] = *(const f32x4*)sp; s1[m] = *(const f32x4*)(sp + 4); } }
                row(acc[ai][0][2 * mp][0], acc[ai][0][2 * mp][1], acc[ai][1][2 * mp][0], acc[ai][1][2 * mp][1], rb + 32 * mp, G, d0, rope, c0[0], c1[0], s0[0], s1[0]);
                row(acc[ai][0][2 * mp + 1][0], acc[ai][0][2 * mp + 1][1], acc[ai][1][2 * mp + 1][0], acc[ai][1][2 * mp + 1][1], rb + 32 * mp + 16, G, d0, rope, c0[1], c1[1], s0[1], s1[1]);
            }
        }
    }
};
struct EpiOut2 {
    static constexpr bool PREFETCH = false;
    bf16* C;
    __device__ __forceinline__ void operator()(const f32x4 (&acc)[2][2][4][2], const pg8::Unit& u, int wr, int wc, int fr, int fq) const {
#pragma unroll
        for (int ai = 0; ai < 2; ++ai)
#pragma unroll
            for (int m = 0; m < 4; ++m) { bf16* rp = C + (size_t)(u.pm * 256 + 128 * ai + 64 * wr + 16 * m + fr) * D + u.pn * 256 + 32 * wc + 8 * fq;
#pragma unroll
                for (int bj = 0; bj < 2; ++bj) st8bf(rp + 128 * bj, acc[ai][bj][m][0], acc[ai][bj][m][1]); }
    }
};
constexpr int SB_OFF = pg8::NA_OFF + 8192;
struct EpiGU2 {
    static constexpr bool PREFETCH = true;
    unsigned char* ACT; const float* bias_l; const float* lhs; float winv;
    __device__ __forceinline__ void prefetch(LAS unsigned char* lds, const pg8::Unit& u, int tid) const {
        const int wv = __builtin_amdgcn_readfirstlane(tid >> 6), i = tid & 255;
        const float* g = tid < 256 ? lhs + (size_t)u.e * T + u.lrow0 + (i < u.nvalid ? i : u.nvalid - 1)
                                   : bias_l + (size_t)u.e * 2048 + 128 * u.pn + (i < 128 ? i : 1024 + (i - 128));
        __builtin_amdgcn_global_load_lds((const unsigned*)g, (LAS unsigned*)(lds + SB_OFF + wv * 256), 4, 0, 0);
    }
    __device__ __forceinline__ void operator()(const f32x4 (&acc)[2][2][4][2], const pg8::Unit& u, int wr, int wc, int fr, int fq, LAS unsigned char* lds) const {
        const LAS float* SC = (const LAS float*)(lds + SB_OFF); const LAS float* BI = SC + 256 + 32 * wc + 8 * fq;
        float sc[2][4];
#pragma unroll
        for (int ai = 0; ai < 2; ++ai)
#pragma unroll
            for (int m = 0; m < 4; ++m) sc[ai][m] = SC[128 * ai + 64 * wr + 16 * m + fr] * winv;
        f32x4 bg[2], bu[2];
#pragma unroll
        for (int n = 0; n < 2; ++n) { bg[n] = *(const LAS f32x4*)(BI + 4 * n); bu[n] = *(const LAS f32x4*)(BI + 128 + 4 * n); }
        float kexp = -1.702f * 1.4426950408889634f, one = 1.f, qs = ACT_QS; asm volatile("" : "+v"(kexp), "+v"(one), "+v"(qs));
#pragma unroll
        for (int ai = 0; ai < 2; ++ai)
#pragma unroll
            for (int mp = 0; mp < 2; ++mp) {
                u32x2 pk[2];
#pragma unroll
                for (int mm = 0; mm < 2; ++mm) { const int m = 2 * mp + mm;
#pragma unroll
                    for (int n = 0; n < 2; ++n) {
                        const f32x4 g = acc[ai][0][m][n] * sc[ai][m] + bg[n], uu = acc[ai][1][m][n] * sc[ai][m] + bu[n];
                        const f32x4 gc = __builtin_elementwise_min(g, (f32x4){7.f, 7.f, 7.f, 7.f});
                        const f32x4 uc = __builtin_elementwise_min(__builtin_elementwise_max(uu, (f32x4){-7.f, -7.f, -7.f, -7.f}), (f32x4){7.f, 7.f, 7.f, 7.f});
                        const f32x4 x = gc * kexp; f32x4 e;
#pragma unroll
                        for (int j = 0; j < 4; ++j) e[j] = __builtin_amdgcn_exp2f(x[j]);
                        const f32x4 dn = e + one; f32x4 rr;
#pragma unroll
                        for (int j = 0; j < 4; ++j) rr[j] = __builtin_amdgcn_rcpf(dn[j]);
                        const f32x4 o = (uc * qs + qs) * (gc * rr);
                        if (n == 0) pk[mm].x = pk4_fp8(o); else pk[mm].y = pk4_fp8(o); } }
                const auto sx = __builtin_amdgcn_permlane16_swap(pk[0].x, pk[1].x, false, false), sy = __builtin_amdgcn_permlane16_swap(pk[0].y, pk[1].y, false, false);
                const int r = 128 * ai + 64 * wr + 16 * (2 * mp + (fq & 1)) + fr;
                if (r < u.nvalid) *(u32x4*)(ACT + (size_t)(u.pm * 256 + r) * FF + 128 * u.pn + 32 * wc + 8 * (fq & ~1)) = (u32x4){(unsigned)sx[0], (unsigned)sy[0], (unsigned)sx[1], (unsigned)sy[1]};
            }
    }
};
struct EpiDN2 {
    static constexpr bool PREFETCH = true;
    bf16* YK; const float* bias_l; const int* list; const float* lgw; float dq;
    __device__ __forceinline__ void prefetch(LAS unsigned char* lds, const pg8::Unit& u, int tid) const {
        const int wv = __builtin_amdgcn_readfirstlane(tid >> 6), i = tid & 255;
        const size_t ri = (size_t)u.e * T + u.lrow0 + (i < u.nvalid ? i : u.nvalid - 1);
        if (wv < 4) {
            __builtin_amdgcn_global_load_lds((const unsigned*)(list + ri), (LAS unsigned*)(lds + SB_OFF + wv * 256), 4, 0, 0);
            __builtin_amdgcn_global_load_lds((const unsigned*)(lgw + ri), (LAS unsigned*)(lds + SB_OFF + 1024 + wv * 256), 4, 0, 0);
        } else
            __builtin_amdgcn_global_load_lds((const unsigned*)(bias_l + (size_t)u.e * D + 256 * u.pn + i), (LAS unsigned*)(lds + SB_OFF + 2048 + (wv - 4) * 256), 4, 0, 0);
    }
    __device__ __forceinline__ void operator()(const f32x4 (&acc)[2][2][4][2], const pg8::Unit& u, int wr, int wc, int fr, int fq, LAS unsigned char* lds) const {
        const LAS int* SL = (const LAS int*)(lds + SB_OFF) + 64 * wr + fr; const LAS float* GW = (const LAS float*)(lds + SB_OFF + 1024) + 64 * wr + fr;
        const LAS float* BI = (const LAS float*)(lds + SB_OFF + 2048) + 32 * wc + 8 * fq;
        int slot[2][4]; float gw[2][4];
#pragma unroll
        for (int ai = 0; ai < 2; ++ai)
#pragma unroll
            for (int m = 0; m < 4; ++m) { slot[ai][m] = SL[128 * ai + 16 * m]; gw[ai][m] = GW[128 * ai + 16 * m]; }
        f32x4 bv[2][2];
#pragma unroll
        for (int bj = 0; bj < 2; ++bj)
#pragma unroll
            for (int n = 0; n < 2; ++n) bv[bj][n] = *(const LAS f32x4*)(BI + 128 * bj + 4 * n);
#pragma unroll
        for (int ai = 0; ai < 2; ++ai)
#pragma unroll
            for (int m = 0; m < 4; ++m) { const int r = 128 * ai + 64 * wr + 16 * m + fr; if (r >= u.nvalid) continue;
#pragma unroll
                for (int bj = 0; bj < 2; ++bj) { const int col = 256 * u.pn + 128 * bj + 32 * wc + 8 * fq;
                    const f32x4 v0 = (acc[ai][bj][m][0] * dq + bv[bj][0]) * gw[ai][m], v1 = (acc[ai][bj][m][1] * dq + bv[bj][1]) * gw[ai][m];
                    u32x4 o; o.x = cvt_pk_bf16(v0.x, v0.y); o.y = cvt_pk_bf16(v0.z, v0.w); o.z = cvt_pk_bf16(v1.x, v1.y); o.w = cvt_pk_bf16(v1.z, v1.w);
                    *(u32x4*)(YK + (size_t)slot[ai][m] * D + col) = o; } }
    }
};

__device__ __forceinline__ void phase_gemm_in(const Frame& F, int l) {
    pg8::StaticOrder So; So.init(T, 3072, F.G, F.bid);
    pg8::gemm_phase<false>(F.lds, (const bf16*)(F.ws + WS_H), pg8::ADense{}, pg8::BDense{(const bf16*)(F.ws + WS_WIN) + (size_t)l * NINP * D}, So, EpiIn2{(unsigned char*)F.ws}, F.tid);
}
__device__ __forceinline__ void phase_gemm_out(const Frame& F, int l) {
    pg8::StaticOrder So; So.init(T, D, F.G, F.bid);
    pg8::gemm_phase<false>(F.lds, (const bf16*)(F.ws + WS_Y), pg8::ADense{}, pg8::BDense{(const bf16*)(F.ws + WS_WOUT) + (size_t)l * D * D}, So, EpiOut2{(bf16*)(F.ws + WS_MIX)}, F.tid);
}
__device__ __forceinline__ void moe_tables(const Frame& F, int l) {
    volatile LAS int* M = (volatile LAS int*)(F.lds + LDS_MISC);
    __syncthreads();
    if (F.tid < 64) {
        const int e = F.lane & 31; const int c = (int)((const unsigned*)(F.ws + WS_CTL) + CW_CNT + l * NE)[e];
        const int tl = (c + 255) >> 8; int inc = tl;
#pragma unroll
        for (int d = 1; d < 32; d <<= 1) { const int o = __shfl_up(inc, d, 32); if (e >= d) inc += o; }
        if (F.lane < 32) { M[16 + e] = c; M[48 + e] = inc - tl; if (e == 31) M[48 + NE] = inc; }
    }
    __syncthreads();
}
template <int WHICH> __device__ __forceinline__ void phase_moe(const Frame& F, int l) {
    constexpr int NCT = WHICH == 0 ? 8 : 4;
    moe_tables(F, l);
    volatile LAS int* M = (volatile LAS int*)(F.lds + LDS_MISC);
    const pg8::MoeOrder So{M, NCT, M[48 + NE] * NCT, F.G, F.bid};
    const int* list = (const int*)(F.ws + WS_LIST);
    const float* wmax = (const float*)((const unsigned*)(F.ws + WS_CTL) + CW_WMAX) + l * 2;
    if (WHICH == 0)
        pg8::gemm_phase<true>(F.lds, (const void*)(F.ws + WS_HQ), pg8::AGather{list}, pg8::BExpert8{(const unsigned char*)(F.ws + WS_WGU) + (size_t)l * NE * 2048 * D, (size_t)2048 * D}, So,
                              EpiGU2{(unsigned char*)(F.ws + WS_ACT), F.in[17] + (size_t)l * NE * 2048, (const float*)(F.ws + WS_LHS), 1.f / w_qscale(wmax[0])}, F.tid);
    else
        pg8::gemm_phase<true>(F.lds, (const void*)(F.ws + WS_ACT), pg8::ADense{}, pg8::BExpert8{(const unsigned char*)(F.ws + WS_WDN) + (size_t)l * NE * D * FF, (size_t)D * FF}, So,
                              EpiDN2{(bf16*)(F.ws + WS_YK), F.in[19] + (size_t)l * NE * D, list, (const float*)(F.ws + WS_LGW), 1.f / (ACT_QS * w_qscale(wmax[1]))}, F.tid);
}


__constant__ float c_log_gamma[4] = {-0.0317486983145803f, -0.015748356968139168f, -0.007843177461025893f, -0.003913899321136329f};
constexpr int RL_Q = 0, RL_K = 16384, RL_KT = 32768, RL_VT = 49152, RL_SP = 65536, RL_ST = 98304;
__device__ __forceinline__ void ret_stage(const Frame& F, int b, int h, int n, bool full, float lg) {
    LAS unsigned char* L = F.lds;
    const int tk = F.tid >> 2, part = F.tid & 3;
    const size_t rowoff = (((size_t)b * 4 + h) * S + n * 128 + tk) * 64 + part * 16;
    const u32x4* kp = (const u32x4*)((const bf16*)(F.ws + WS_PRK) + rowoff);
    const u32x4* vp = (const u32x4*)((const bf16*)(F.ws + WS_PRV) + rowoff);
    const u32x4 k0 = kp[0], k1 = kp[1], v0 = vp[0], v1 = vp[1];
    if (full) { const u32x4* qp = (const u32x4*)((const bf16*)(F.ws + WS_PRQ) + rowoff);
        const u32x4 q0 = qp[0], q1 = qp[1];
        *(LAS u32x4*)(L + RL_Q + tk * 128 + part * 32) = q0; *(LAS u32x4*)(L + RL_Q + tk * 128 + part * 32 + 16) = q1;
        *(LAS u32x4*)(L + RL_K + tk * 128 + part * 32) = k0; *(LAS u32x4*)(L + RL_K + tk * 128 + part * 32 + 16) = k1; }
    const float kd = expf((float)(127 - tk) * lg);
    const unsigned kw[8] = {k0.x, k0.y, k0.z, k0.w, k1.x, k1.y, k1.z, k1.w}, vw[8] = {v0.x, v0.y, v0.z, v0.w, v1.x, v1.y, v1.z, v1.w};
#pragma unroll
    for (int i = 0; i < 8; ++i) { const int d = part * 16 + 2 * i;
        if (!full) { const unsigned pk = cvt_pk_bf16(bf2f((unsigned short)(kw[i] & 0xffffu)) * kd, bf2f((unsigned short)(kw[i] >> 16)) * kd);
            *(LAS unsigned short*)(L + RL_KT + (d * 128 + tk) * 2) = (unsigned short)(pk & 0xffffu); *(LAS unsigned short*)(L + RL_KT + ((d + 1) * 128 + tk) * 2) = (unsigned short)(pk >> 16); }
        *(LAS unsigned short*)(L + RL_VT + (d * 128 + tk) * 2) = (unsigned short)(vw[i] & 0xffffu); *(LAS unsigned short*)(L + RL_VT + ((d + 1) * 128 + tk) * 2) = (unsigned short)(vw[i] >> 16); }
}
__device__ __forceinline__ void ret_kv_unit(const Frame& F, int unit) {
    const int n = unit & 15, h = (unit >> 4) & 3, b = unit >> 6;
    const float lg = c_log_gamma[h];
    LAS unsigned char* L = F.lds;
    __syncthreads();
    ret_stage(F, b, h, n, false, lg);
    __syncthreads();
    const int fr = F.lane & 15, fq = F.lane >> 4, dtile = F.wave >> 1, et0 = (F.wave & 1) * 2;
    f32x4 a0 = {0.f, 0.f, 0.f, 0.f}, a1 = {0.f, 0.f, 0.f, 0.f};
#pragma unroll
    for (int ks = 0; ks < 4; ++ks) {
        const bf16x8 a = *(const LAS bf16x8*)(L + RL_KT + ((16 * dtile + fr) * 128 + 32 * ks + fq * 8) * 2);
        const bf16x8 b0 = *(const LAS bf16x8*)(L + RL_VT + ((16 * et0 + fr) * 128 + 32 * ks + fq * 8) * 2);
        const bf16x8 b1 = *(const LAS bf16x8*)(L + RL_VT + ((16 * (et0 + 1) + fr) * 128 + 32 * ks + fq * 8) * 2);
        a0 = __builtin_amdgcn_mfma_f32_16x16x32_bf16(a, b0, a0, 0, 0, 0); a1 = __builtin_amdgcn_mfma_f32_16x16x32_bf16(a, b1, a1, 0, 0, 0);
    }
    float* kv = (float*)(F.ws + WS_KVB) + ((((size_t)b * 4 + h) * 16 + n) * 64) * 64;
#pragma unroll
    for (int j = 0; j < 4; ++j) { const int d = 16 * dtile + fq * 4 + j; kv[d * 64 + 16 * et0 + fr] = a0[j]; kv[d * 64 + 16 * (et0 + 1) + fr] = a1[j]; }
}
__device__ __forceinline__ void ret_out_unit(const Frame& F, int l, int unit) {
    const int n = unit & 15, h = (unit >> 4) & 3, b = unit >> 6;
    const float lg = c_log_gamma[h];
    LAS unsigned char* L = F.lds;
    __syncthreads();
    ret_stage(F, b, h, n, true, lg);
    {
        const int idx8 = F.tid * 8, d = idx8 >> 6, e0 = idx8 & 63;
        f32x4 s0 = {0.f, 0.f, 0.f, 0.f}, s1 = {0.f, 0.f, 0.f, 0.f};
        const float* kvb = (const float*)(F.ws + WS_KVB) + (((size_t)b * 4 + h) * 16) * 4096 + idx8;
#pragma unroll
        for (int mb = 0; mb < 16; mb += 8) {
            f32x4 t0[8], t1[8];
#pragma unroll
            for (int q = 0; q < 8; ++q) { const int m = mb + q; const bool ok = m < n;
                t0[q] = ok ? *(const f32x4*)(kvb + (size_t)m * 4096) : (f32x4){0.f, 0.f, 0.f, 0.f}; t1[q] = ok ? *(const f32x4*)(kvb + (size_t)m * 4096 + 4) : (f32x4){0.f, 0.f, 0.f, 0.f}; }
#pragma unroll
            for (int q = 0; q < 8; ++q) { const int m = mb + q; const float coef = m < n ? __expf((float)(n - 1 - m) * 128.f * lg) : 0.f; s0 += coef * t0[q]; s1 += coef * t1[q]; }
        }
        const unsigned p0 = cvt_pk_bf16(s0.x, s0.y), p1 = cvt_pk_bf16(s0.z, s0.w), p2 = cvt_pk_bf16(s1.x, s1.y), p3 = cvt_pk_bf16(s1.z, s1.w);
        const unsigned pk[4] = {p0, p1, p2, p3};
#pragma unroll
        for (int i = 0; i < 4; ++i) { *(LAS unsigned short*)(L + RL_ST + ((e0 + 2 * i) * 64 + d) * 2) = (unsigned short)(pk[i] & 0xffffu); *(LAS unsigned short*)(L + RL_ST + ((e0 + 2 * i + 1) * 64 + d) * 2) = (unsigned short)(pk[i] >> 16); }
    }
    __syncthreads();
    const int fr = F.lane & 15, fq = F.lane >> 4, w = F.wave, i0 = 16 * w;
    for (int jt = 0; jt <= (w | 1); ++jt) {
        f32x4 acc = {0.f, 0.f, 0.f, 0.f};
#pragma unroll
        for (int ks = 0; ks < 2; ++ks) {
            const bf16x8 a = *(const LAS bf16x8*)(L + RL_Q + ((i0 + fr) * 64 + 32 * ks + fq * 8) * 2);
            const bf16x8 bb = *(const LAS bf16x8*)(L + RL_K + ((16 * jt + fr) * 64 + 32 * ks + fq * 8) * 2);
            acc = __builtin_amdgcn_mfma_f32_16x16x32_bf16(a, bb, acc, 0, 0, 0);
        }
#pragma unroll
        for (int j = 0; j < 4; ++j) { const int i = i0 + fq * 4 + j, jj = 16 * jt + fr;
            const float val = i >= jj ? acc[j] * expf((float)(i - jj) * lg) : 0.f;
            *(LAS unsigned short*)(L + RL_SP + (i * 128 + jj) * 2) = (unsigned short)(cvt_pk_bf16(val, val) & 0xffffu); }
    }
    LDS_WAIT();
    f32x4 acc1[4], acc2[4];
#pragma unroll
    for (int dt = 0; dt < 4; ++dt) { acc1[dt] = (f32x4){0.f, 0.f, 0.f, 0.f}; acc2[dt] = (f32x4){0.f, 0.f, 0.f, 0.f}; }
    for (int ks = 0; ks <= (w >> 1); ++ks) {
        const bf16x8 a = *(const LAS bf16x8*)(L + RL_SP + ((i0 + fr) * 128 + 32 * ks + fq * 8) * 2);
#pragma unroll
        for (int dt = 0; dt < 4; ++dt) { const bf16x8 bb = *(const LAS bf16x8*)(L + RL_VT + ((16 * dt + fr) * 128 + 32 * ks + fq * 8) * 2);
            acc1[dt] = __builtin_amdgcn_mfma_f32_16x16x32_bf16(a, bb, acc1[dt], 0, 0, 0); }
    }
#pragma unroll
    for (int ks = 0; ks < 2; ++ks) {
        const bf16x8 a = *(const LAS bf16x8*)(L + RL_Q + ((i0 + fr) * 64 + 32 * ks + fq * 8) * 2);
#pragma unroll
        for (int dt = 0; dt < 4; ++dt) { const bf16x8 bb = *(const LAS bf16x8*)(L + RL_ST + ((16 * dt + fr) * 64 + 32 * ks + fq * 8) * 2);
            acc2[dt] = __builtin_amdgcn_mfma_f32_16x16x32_bf16(a, bb, acc2[dt], 0, 0, 0); }
    }
    const float* gnw = F.in[5] + l * 256 + h * 64;
#pragma unroll
    for (int j = 0; j < 4; ++j) {
        const int i = i0 + fq * 4 + j; const float qd = expf((float)(i + 1) * lg);
        float o[4], sm = 0.f;
#pragma unroll
        for (int dt = 0; dt < 4; ++dt) { o[dt] = acc1[dt][j] + qd * acc2[dt][j]; sm += o[dt]; }
        sm += __shfl_xor(sm, 1); sm += __shfl_xor(sm, 2); sm += __shfl_xor(sm, 4); sm += __shfl_xor(sm, 8);
        const float mean = sm * (1.f / 64.f); float vs = 0.f;
#pragma unroll
        for (int dt = 0; dt < 4; ++dt) { o[dt] -= mean; vs += o[dt] * o[dt]; }
        vs += __shfl_xor(vs, 1); vs += __shfl_xor(vs, 2); vs += __shfl_xor(vs, 4); vs += __shfl_xor(vs, 8);
        const float rstd = 1.f / sqrtf(vs * (1.f / 64.f) + LN_EPS);
        const size_t tok = (size_t)b * S + n * 128 + i;
#pragma unroll
        for (int dt = 0; dt < 4; ++dt) { const int e = 16 * dt + fr;
            const float rg = bf2f(((const bf16*)(F.ws + WS_RG))[tok * 256 + h * 64 + e]);
            const float yv = o[dt] * rstd * gnw[e] * (rg * sigmoidf_(rg));
            ((bf16*)(F.ws + WS_Y))[tok * D + h * 64 + e] = (bf16)(cvt_pk_bf16(yv, yv) & 0xffffu); }
    }
}
__device__ __forceinline__ void conv_tokens(const Frame& F, int l, int wg0) {
    const int gw = (F.bid - wg0) * NWAVES + F.wave, NGW = (F.G - wg0) * NWAVES, lane = F.lane;
    const bf16* CV = (const bf16*)(F.ws + WS_CV); bf16* Y = (bf16*)(F.ws + WS_Y);
    const float* cw = F.in[6] + (size_t)l * 3 * 256 + lane * 4;
    const f32x4 w0 = *(const f32x4*)cw, w1 = *(const f32x4*)(cw + 256), w2 = *(const f32x4*)(cw + 512);
    for (int tok0 = gw; tok0 < T; tok0 += 4 * NGW) {
        u32x2 c[4][3], hh[4][3], bb[4];
#pragma unroll
        for (int q = 0; q < 4; ++q) { const int tok = tok0 + q * NGW; const int t = tok & (S - 1);
            const bf16* p = CV + (size_t)(tok < T ? tok : gw) * 768 + lane * 4;
            bb[q] = *(const u32x2*)p;
#pragma unroll
            for (int k = 0; k < 3; ++k) { const bf16* pk = p - (size_t)(t >= k ? k : 0) * 768; c[q][k] = *(const u32x2*)(pk + 256); hh[q][k] = *(const u32x2*)(pk + 512); } }
#pragma unroll
        for (int q = 0; q < 4; ++q) { const int tok = tok0 + q * NGW; const int t = tok & (S - 1);
            if (tok >= T) continue;
            f32x4 u[3];
#pragma unroll
            for (int k = 0; k < 3; ++k) { const f32x4 m = bf4(c[q][k]) * bf4(hh[q][k]); u[k] = t >= k ? m : (f32x4){0.f, 0.f, 0.f, 0.f}; }
            st4bf(Y + (size_t)tok * D + 256 + lane * 4, bf4(bb[q]) * (w0 * u[2] + w1 * u[1] + w2 * u[0]));
        }
    }
}

typedef float f32x16 __attribute__((ext_vector_type(16)));
typedef short s16x4 __attribute__((ext_vector_type(4)));
#define MFMA32(a, b, c) __builtin_amdgcn_mfma_f32_32x32x16_bf16((a), (b), (c), 0, 0, 0)
__device__ __forceinline__ bf16x8 pack_step(const f32x16& x, int s) {
    u32x4 p;
    asm volatile("v_cvt_pk_bf16_f32 %0, %4, %5\n\tv_cvt_pk_bf16_f32 %1, %6, %7\n\tv_cvt_pk_bf16_f32 %2, %8, %9\n\tv_cvt_pk_bf16_f32 %3, %10, %11\n\ts_nop 1"
                 : "=&v"(p[0]), "=&v"(p[1]), "=&v"(p[2]), "=&v"(p[3])
                 : "v"(x[8 * s]), "v"(x[8 * s + 1]), "v"(x[8 * s + 2]), "v"(x[8 * s + 3]), "v"(x[8 * s + 4]), "v"(x[8 * s + 5]), "v"(x[8 * s + 6]), "v"(x[8 * s + 7]));
    return __builtin_bit_cast(bf16x8, p);
}
constexpr int NL_KC = 0, NL_VC = 18432  , NL_OUT = 54272;

constexpr float NSA_DEFER = 8.f;
constexpr int NL_SLOT = 17920;
struct NsaBr { const bf16* Kp; const bf16* Vp; int srow, spart, r, h, t, qt, jlo; unsigned selmask; bool hiw; };
#define NSA_PRIO_ON(c) do { if ((c).hiw) __builtin_amdgcn_s_setprio(3); else __builtin_amdgcn_s_setprio(1); } while (0)
#define NSA_PRIO_OFF() __builtin_amdgcn_s_setprio(0)
template <int BR> __device__ __forceinline__ void nsa_s_tile(LAS unsigned char* L, int slot, const NsaBr& c, const bf16x8 (&qr)[4], f32x16 (&sa)[2]) {
    NSA_PRIO_ON(c);
#pragma unroll
    for (int kt = 0; kt < 2; ++kt) {
#pragma unroll
        for (int i = 0; i < 16; ++i) sa[kt][i] = 0.f;
#pragma unroll
        for (int ks = 0; ks < 4; ++ks) { const bf16x8 a = *(const LAS bf16x8*)(L + slot + (32 * kt + c.r) * 144 + (16 * ks + 8 * c.h) * 2); sa[kt] = MFMA32(a, qr[ks], sa[kt]); }
    }
    NSA_PRIO_OFF();
}
template <int BR> __device__ __forceinline__ void nsa_softmax_pv(LAS unsigned char* L, int slot, const NsaBr& c, int j, f32x16 (&sa)[2], f32x16 (&oacc)[2], float& mrun, float& lrun) {
    const int h = c.h, r = c.r, t = c.t;
    const bool mine = BR == 1 ? ((c.selmask >> j) & 1u) != 0u : true;
    float mblk = -1e30f;
    const bool edge = (j == c.qt) || (BR == 2 && c.qt >= 8 && j == c.jlo);
    if (edge) {
#pragma unroll
        for (int kt = 0; kt < 2; ++kt)
#pragma unroll
            for (int i = 0; i < 16; ++i) { const int key = 64 * j + 32 * kt + (i & 3) + 8 * (i >> 2) + 4 * h;
                int pb = (t - key) >> 31;
                if (BR == 2) pb |= (key - (t - 511)) >> 31;
                const float v = sa[kt][i] + __int_as_float(pb & (int)0xF149F2CA); sa[kt][i] = v; mblk = fmaxf(mblk, v); }
    } else {
#pragma unroll
        for (int kt = 0; kt < 2; ++kt)
#pragma unroll
            for (int i = 0; i < 16; i += 2) mblk = fmaxf(mblk, fmaxf(sa[kt][i], sa[kt][i + 1]));
    }
    if (BR == 1) mblk = mine ? mblk : -1e30f;
    mblk = fmaxf(mblk, __shfl_xor(mblk, 32));
    if (__any(mblk > mrun + NSA_DEFER)) {
        const float mnew = fmaxf(mrun, mblk);
        const float alpha = __builtin_amdgcn_exp2f(mrun - mnew);
        lrun *= alpha; mrun = mnew;
#pragma unroll
        for (int i = 0; i < 16; ++i) { oacc[0][i] *= alpha; oacc[1][i] *= alpha; }
    }
    const float msub = (BR == 1 && !mine) ? 1e30f : mrun;
    f32x2 ps2 = {0.f, 0.f}; float nmsub = -msub; asm volatile("" : "+v"(nmsub)); const f32x2 nm2 = {nmsub, nmsub};
#pragma unroll
    for (int kt = 0; kt < 2; ++kt) {
#pragma unroll
        for (int i = 0; i < 16; i += 2) { const f32x2 x = (f32x2){sa[kt][i], sa[kt][i + 1]} + nm2; sa[kt][i] = __builtin_amdgcn_exp2f(x.x); sa[kt][i + 1] = __builtin_amdgcn_exp2f(x.y); }
#pragma unroll
        for (int i = 0; i < 16; i += 2) ps2 += (f32x2){sa[kt][i], sa[kt][i + 1]};
    }
    const float psum = ps2.x + ps2.y;
    lrun += psum;
    NSA_PRIO_ON(c);
#pragma unroll
    for (int kt = 0; kt < 2; ++kt)
#pragma unroll
        for (int s2 = 0; s2 < 2; ++s2) { const bf16x8 pf = pack_step(sa[kt], s2);
#pragma unroll
            for (int dt = 0; dt < 2; ++dt) { const LAS unsigned char* vp = L + slot + 9216 + (32 * dt + r) * 136 + (32 * kt + 16 * s2 + 4 * h) * 2;
                const s16x4 lo = *(const LAS s16x4*)vp, hi = *(const LAS s16x4*)(vp + 16);
                const bf16x8 vf = __builtin_shufflevector(lo, hi, 0, 1, 2, 3, 4, 5, 6, 7);
                oacc[dt] = MFMA32(vf, pf, oacc[dt]); } }
    NSA_PRIO_OFF();
}
__device__ __forceinline__ void nsa_kv_load(const NsaBr& c, int j, u32x4& kreg, u32x4& vreg) {
    kreg = *(const u32x4*)(c.Kp + (size_t)(64 * j + c.srow) * 64 + c.spart * 8); vreg = *(const u32x4*)(c.Vp + (size_t)c.srow * S + 64 * j + c.spart * 8);
}
__device__ __forceinline__ void nsa_kv_write(LAS unsigned char* L, int slot, const NsaBr& c, const u32x4& kreg, const u32x4& vreg) {
    *(LAS u32x4*)(L + slot + c.srow * 144 + c.spart * 16) = kreg;
    LAS u32x2* vd = (LAS u32x2*)(L + slot + 9216 + c.srow * 136 + c.spart * 16); vd[0] = (u32x2){vreg.x, vreg.y}; vd[1] = (u32x2){vreg.z, vreg.w};
}
template <int BR> __device__ __forceinline__ void nsa_step(LAS unsigned char* L, const NsaBr& c, const bf16x8 (&qr)[4], int jj, int nblk, int s_cur, int s_nxt, int s_wr,
                                                            u32x4& kreg, u32x4& vreg, f32x16 (&cur)[2], f32x16 (&nxt)[2], f32x16 (&oacc)[2], float& mrun, float& lrun) {
    LDS_BARRIER();
    if (jj + 2 < nblk) { nsa_kv_write(L, s_wr, c, kreg, vreg); if (jj + 3 < nblk) nsa_kv_load(c, c.jlo + jj + 3, kreg, vreg); }
    if (jj + 1 < nblk) nsa_s_tile<BR>(L, s_nxt, c, qr, nxt);
    nsa_softmax_pv<BR>(L, s_cur, c, c.jlo + jj, cur, oacc, mrun, lrun);
}
template <int BR>
__device__ __forceinline__ void nsa_branch(const Frame& F, int plane, int qt, int t, int r, int h, unsigned selmask, const bf16x8 (&qr)[4], float gate) {
    LAS unsigned char* L = F.lds;
    NsaBr c;
    c.Kp = (const bf16*)(F.ws + (BR == 1 ? WS_NKS : WS_NKW)) + (size_t)plane * S * 64;
    c.Vp = (const bf16*)(F.ws + (BR == 1 ? WS_NVST : WS_NVWT)) + (size_t)plane * 64 * S;
    c.jlo = BR == 1 ? 0 : (qt > 8 ? qt - 8 : 0); c.srow = F.tid >> 3; c.spart = F.tid & 7; c.r = r; c.h = h; c.t = t; c.qt = qt; c.selmask = selmask; c.hiw = F.wave < 4;
    const int nblk = qt - c.jlo + 1;
    u32x4 kreg, vreg;
    f32x16 oacc[2], sa[2], sb[2];
#pragma unroll
    for (int i = 0; i < 16; ++i) { oacc[0][i] = 0.f; oacc[1][i] = 0.f; }
    float mrun = -1e20f, lrun = 0.f;
    nsa_kv_load(c, c.jlo, kreg, vreg);
    LDS_BARRIER();
    nsa_kv_write(L, 0, c, kreg, vreg);
    if (nblk > 1) nsa_kv_load(c, c.jlo + 1, kreg, vreg);
    LDS_BARRIER();
    if (nblk > 1) { nsa_kv_write(L, NL_SLOT, c, kreg, vreg); if (nblk > 2) nsa_kv_load(c, c.jlo + 2, kreg, vreg); }
    nsa_s_tile<BR>(L, 0, c, qr, sa);
    int s0 = 0, s1 = NL_SLOT, s2 = 2 * NL_SLOT;
#pragma unroll 1
    for (int jj = 0; jj < nblk; jj += 2) {
        nsa_step<BR>(L, c, qr, jj, nblk, s0, s1, s2, kreg, vreg, sa, sb, oacc, mrun, lrun);
        if (jj + 1 < nblk) nsa_step<BR>(L, c, qr, jj + 1, nblk, s1, s2, s0, kreg, vreg, sb, sa, oacc, mrun, lrun);
        const int tmp = s0; s0 = s2; s2 = s1; s1 = tmp;
    }
    const float ltot = lrun + __shfl_xor(lrun, 32);
    const float sc = ltot > 0.f ? gate / ltot : 0.f;
    LAS float* ob = (LAS float*)(L + NL_OUT + F.wave * 8192) + F.lane;
#pragma unroll
    for (int i = 0; i < 16; ++i) { ob[i * 64] += oacc[0][i] * sc; ob[(16 + i) * 64] += oacc[1][i] * sc; }
}

__device__ __forceinline__ void nsa_unit(const Frame& F, int plane, int qt) {
    LAS unsigned char* L = F.lds;
    const int lane = F.lane, r = lane & 31, h = lane >> 5, w = F.wave;
    const int b = plane >> 1, kvh = plane & 1, g = r & 3, head = kvh * 4 + g;
    const int t = qt * 64 + w * 8 + (r >> 2), cur = qt;
    const size_t tok = (size_t)b * S + t;
    const size_t qoff = (((size_t)b * 8 + head) * S + t) * 64 + 8 * h;
    const float* ng = (const float*)(F.ws + WS_NG) + tok * 24 + head * 3;
    const float gate_c = ng[0], gate_s = ng[1], gate_w = ng[2];
    unsigned selmask = 0u;
    __syncthreads();
    { const int row = F.tid >> 2, part = F.tid & 3;
      const u32x4* src = (const u32x4*)((const bf16*)(F.ws + WS_KCB) + ((size_t)plane * 128 + row) * 64 + part * 16);
      *(LAS u32x4*)(L + NL_KC + row * 144 + part * 32) = src[0]; *(LAS u32x4*)(L + NL_KC + row * 144 + part * 32 + 16) = src[1];
      const int d = F.tid >> 3, p8 = F.tid & 7;
      const u32x4* sv = (const u32x4*)((const bf16*)(F.ws + WS_VCT) + ((size_t)plane * 64 + d) * 128 + p8 * 16);
      *(LAS u32x4*)(L + NL_VC + d * 272 + p8 * 32) = sv[0]; *(LAS u32x4*)(L + NL_VC + d * 272 + p8 * 32 + 16) = sv[1]; }
    __syncthreads();
    {
        bf16x8 qu[4];
#pragma unroll
        for (int ks = 0; ks < 4; ++ks) qu[ks] = *(const bf16x8*)((const bf16*)(F.ws + WS_NQU) + qoff + 16 * ks);
        const int cmax = (t - 31) >> 4;
        float mx = -1e20f;
#pragma unroll
        for (int ct = 0; ct < 4; ++ct) {
            f32x16 sc;
#pragma unroll
            for (int i = 0; i < 16; ++i) sc[i] = 0.f;
#pragma unroll
            for (int ks = 0; ks < 4; ++ks) { const bf16x8 a = *(const LAS bf16x8*)(L + NL_KC + (32 * ct + r) * 144 + (16 * ks + 8 * h) * 2); sc = MFMA32(a, qu[ks], sc); }
#pragma unroll
            for (int i = 0; i < 16; ++i) { const int c = 32 * ct + (i & 3) + 8 * (i >> 2) + 4 * h; mx = fmaxf(mx, sc[i] + __int_as_float(((cmax - c) >> 31) & (int)0xF149F2CA)); }
        }
        mx = fmaxf(mx, __shfl_xor(mx, 32));
        float imp[16];
        float ls = 0.f, prev = 0.f;
        f32x16 outacc[2];
#pragma unroll
        for (int i = 0; i < 16; ++i) { outacc[0][i] = 0.f; outacc[1][i] = 0.f; }
#pragma unroll
        for (int ct = 0; ct < 4; ++ct) {
            f32x16 sc;
#pragma unroll
            for (int i = 0; i < 16; ++i) sc[i] = 0.f;
#pragma unroll
            for (int ks = 0; ks < 4; ++ks) { const bf16x8 a = *(const LAS bf16x8*)(L + NL_KC + (32 * ct + r) * 144 + (16 * ks + 8 * h) * 2); sc = MFMA32(a, qu[ks], sc); }
#pragma unroll
            for (int i = 0; i < 16; ++i) { const int c = 32 * ct + (i & 3) + 8 * (i >> 2) + 4 * h; const float e = __builtin_amdgcn_exp2f(sc[i] + __int_as_float(((cmax - c) >> 31) & (int)0xF149F2CA) - mx); sc[i] = e; ls += e; }
#pragma unroll
            for (int q = 0; q < 4; ++q) { const float ok = __shfl_xor(sc[4 * q + 3], 32);
                imp[4 * ct + q] = ((sc[4 * q] + sc[4 * q + 1]) + (sc[4 * q + 2] + sc[4 * q + 3])) + (h ? ok : prev); prev = ok; }
#pragma unroll
            for (int s2 = 0; s2 < 2; ++s2) { const bf16x8 pf = pack_step(sc, s2);
#pragma unroll
                for (int dt = 0; dt < 2; ++dt) { const LAS unsigned char* vp = L + NL_VC + (32 * dt + r) * 272 + (32 * ct + 16 * s2 + 4 * h) * 2;
                    const s16x4 lo = *(const LAS s16x4*)vp, hi = *(const LAS s16x4*)(vp + 16);
                    const bf16x8 vf = __builtin_shufflevector(lo, hi, 0, 1, 2, 3, 4, 5, 6, 7);
                    outacc[dt] = MFMA32(vf, pf, outacc[dt]); } }
            __builtin_amdgcn_sched_barrier(0);
        }
        ls += __shfl_xor(ls, 32);
        const float inv = ls > 0.f ? 1.f / ls : 0.f;
#pragma unroll
        for (int k = 0; k < 16; ++k) imp[k] *= inv;
        { LAS float* ob = (LAS float*)(L + NL_OUT + w * 8192) + lane; const float og = inv * gate_c;
#pragma unroll
          for (int i = 0; i < 16; ++i) { ob[i * 64] = outacc[0][i] * og; ob[(16 + i) * 64] = outacc[1][i] * og; } }
#pragma unroll
        for (int k = 0; k < 16; ++k) { imp[k] += __shfl_xor(imp[k], 1); imp[k] += __shfl_xor(imp[k], 2);
            const int jb = 2 * k + h; imp[k] = (jb == 0 || jb == cur) ? 1e9f : (jb <= cur ? imp[k] : -1e9f); }
#pragma unroll 1
        for (int round = 0; round < 8; ++round) {
            float bv = imp[0]; int bj = h;
#pragma unroll
            for (int k = 1; k < 16; ++k) { const bool tk = imp[k] > bv; bv = tk ? imp[k] : bv; bj = tk ? 2 * k + h : bj; }
            const float ov = __shfl_xor(bv, 32); const int oj = __shfl_xor(bj, 32);
            const bool take = (ov > bv) || (ov == bv && oj < bj);
            bj = take ? oj : bj;
            selmask |= 1u << bj;
#pragma unroll
            for (int k = 0; k < 16; ++k) imp[k] = (2 * k + h == bj) ? -INFINITY : imp[k];
        }
    }
    bf16x8 qr[4];
#pragma unroll
    for (int ks = 0; ks < 4; ++ks) qr[ks] = *(const bf16x8*)((const bf16*)(F.ws + WS_NQRB) + qoff + 16 * ks);
    nsa_branch<1>(F, plane, qt, t, r, h, selmask, qr, gate_s);
    nsa_branch<2>(F, plane, qt, t, r, h, 0u, qr, gate_w);
    bf16* yp = (bf16*)(F.ws + WS_Y) + tok * D + 512 + head * 64;
    { const LAS float* ob = (const LAS float*)(L + NL_OUT + w * 8192) + lane;
#pragma unroll
      for (int dt = 0; dt < 2; ++dt)
#pragma unroll
        for (int q = 0; q < 4; ++q) st4bf(yp + 32 * dt + 8 * q + 4 * h, (f32x4){ob[(16 * dt + 4 * q) * 64], ob[(16 * dt + 4 * q + 1) * 64], ob[(16 * dt + 4 * q + 2) * 64], ob[(16 * dt + 4 * q + 3) * 64]}); }
}

constexpr int CL_HD = 49152;
struct RowCmp { int p0; __device__ __forceinline__ int operator()(int r) const { return (p0 + (r >> 7)) * 128 + (r & 127); } };
struct EpiCmp {
    LAS unsigned char* lds; unsigned char* ws; const float* bias1; const bf16* w2t; int which, p0, wave;
    __device__ __forceinline__ void operator()(const f32x4 (&acc)[4][4], const GemmCtx& cx) const {
        __syncthreads();
#pragma unroll
        for (int m = 0; m < 4; ++m) { const int rr = cx.wr * 64 + m * 16 + cx.fr;
#pragma unroll
            for (int n = 0; n < 4; ++n) { const int col = cx.wc * 64 + n * 16 + cx.fq * 4; const f32x4 bv = *(const f32x4*)(bias1 + col);
                f32x4 x = acc[m][n] + bv, o;
#pragma unroll
                for (int j = 0; j < 4; ++j) { const float xv = x[j]; o[j] = 0.5f * xv * (1.f + tanhf(0.7978845608028654f * (xv + 0.044715f * xv * xv * xv))); }
                u32x2 pk; pk.x = cvt_pk_bf16(o[0], o[1]); pk.y = cvt_pk_bf16(o[2], o[3]);
                *(LAS u32x2*)(lds + CL_HD + rr * 272 + col * 2) = pk; } }
        __syncthreads();
        f32x4 o2[2][4];
#pragma unroll
        for (int mt = 0; mt < 2; ++mt)
#pragma unroll
            for (int nt = 0; nt < 4; ++nt) o2[mt][nt] = (f32x4){0.f, 0.f, 0.f, 0.f};
#pragma unroll
        for (int ks = 0; ks < 4; ++ks) {
            bf16x8 a[2], bq[4];
#pragma unroll
            for (int mt = 0; mt < 2; ++mt) a[mt] = *(const LAS bf16x8*)(lds + CL_HD + (32 * wave + 16 * mt + cx.fr) * 272 + (32 * ks + cx.fq * 8) * 2);
#pragma unroll
            for (int nt = 0; nt < 4; ++nt) bq[nt] = *(const bf16x8*)(w2t + (16 * nt + cx.fr) * 128 + 32 * ks + cx.fq * 8);
#pragma unroll
            for (int mt = 0; mt < 2; ++mt)
#pragma unroll
                for (int nt = 0; nt < 4; ++nt) o2[mt][nt] = __builtin_amdgcn_mfma_f32_16x16x32_bf16(bq[nt], a[mt], o2[mt][nt], 0, 0, 0);
        }
#pragma unroll
        for (int mt = 0; mt < 2; ++mt) { const int rr = 32 * wave + 16 * mt + cx.fr, plane = p0 + (rr >> 7), c = rr & 127;
#pragma unroll
            for (int nt = 0; nt < 4; ++nt) { const int d0 = 16 * nt + cx.fq * 4;
                if (which == 0) st4bf((bf16*)(ws + WS_KCB) + ((size_t)plane * 128 + c) * 64 + d0, o2[mt][nt]);
                else {
#pragma unroll
                    for (int j = 0; j < 4; ++j) ((bf16*)(ws + WS_VCT))[((size_t)plane * 64 + d0 + j) * 128 + c] = (bf16)(cvt_pk_bf16(o2[mt][nt][j], o2[mt][nt][j]) & 0xffffu); } } }
    }
};

__device__ __forceinline__ void gates_tiles(const Frame& F, int l, int wg0) {
    const int NGW = (F.G - wg0) * NWAVES, gw = NGW - 1 - ((F.bid - wg0) * NWAVES + F.wave), fr = F.lane & 15, fq = F.lane >> 4;
    const bf16* H = (const bf16*)(F.ws + WS_H); const bf16* WG = (const bf16*)(F.ws + WS_WIN) + ((size_t)l * NINP + 3072) * D;
    for (int rt = gw; rt < T / 16; rt += NGW) {
        f32x4 a0 = {0.f, 0.f, 0.f, 0.f}, a1 = {0.f, 0.f, 0.f, 0.f};
        const bf16* ap = H + (size_t)(16 * rt + fr) * D + 8 * fq; const bf16* bp = WG + (size_t)fr * D + 8 * fq;
#pragma unroll 8
        for (int ks = 0; ks < 32; ++ks) { const bf16x8 a = *(const bf16x8*)(ap + 32 * ks), b0 = *(const bf16x8*)(bp + 32 * ks), b1 = *(const bf16x8*)(bp + 16 * D + 32 * ks);
            a0 = __builtin_amdgcn_mfma_f32_16x16x32_bf16(b0, a, a0, 0, 0, 0); a1 = __builtin_amdgcn_mfma_f32_16x16x32_bf16(b1, a, a1, 0, 0, 0); }
        float* ng = (float*)(F.ws + WS_NG) + (size_t)(16 * rt + fr) * 24;
#pragma unroll
        for (int j = 0; j < 4; ++j) { ng[4 * fq + j] = sigmoidf_(a0[j]); if (fq < 2) ng[16 + 4 * fq + j] = sigmoidf_(a1[j]); }
    }
}
__device__ __forceinline__ void phase_prep(const Frame& F, int l) {
    if (FAST_RET && FAST_NSA) {
        const int first = F.G > 32 ? 16 : 0;
        if (F.bid < first || first == 0) {
            for (int u = F.bid; u < 16; u += F.G) { const int which = u >> 3, p0 = (u & 7) * 2, lw = l * 2 + which;
                RowCmp R{p0}; EpiCmp E{F.lds, (unsigned char*)F.ws, (const float*)(F.ws + WS_CB1) + lw * 128, (const bf16*)(F.ws + WS_CW2T) + (size_t)lw * 64 * 128, which, p0, F.wave};
                gemm_unit(F, (const bf16*)(F.ws + (which ? WS_NVC : WS_NKC)), R, (const bf16*)(F.ws + WS_CW1T) + (size_t)lw * 128 * 2048, E, 64, 2048); }
            __syncthreads();
        }
        if (F.bid >= first) {
            conv_tokens(F, l, first); for (int u = F.bid - first; u < NB * 4 * 16; u += F.G - first) ret_kv_unit(F, u); __syncthreads();
            gates_tiles(F, l, first);
            fp8_convert_range(F, l, F.bid - first, F.G - first, CONV_SPLIT);
        }
        return;
    }
    const int gw = F.bid * NWAVES + F.wave, NGW = F.G * NWAVES, lane = F.lane;
    const float* PROJ = (const float*)(F.ws + WS_PROJ);
    float* RQ = (float*)(F.ws + WS_RQ); float* RK = (float*)(F.ws + WS_RK); float* NQR = (float*)(F.ws + WS_NQR);
    float* KSR = (float*)(F.ws + WS_KSR); float* KWR = (float*)(F.ws + WS_KWR); bf16* Y = (bf16*)(F.ws + WS_Y);
    for (int tok = gw; tok < T; tok += NGW) {
        const int t = tok & (S - 1);
        const float* p = PROJ + (size_t)tok * PLD;
        const float cv = ((const float*)(F.ws + WS_ROPEC))[tok * 32 + (lane & 31)], sv = ((const float*)(F.ws + WS_ROPES))[tok * 32 + (lane & 31)];
        const float sg = lane < 32 ? -sv : sv;
#define ROPE(v) ((v) * cv + __shfl_xor((v), 32) * sg)
        if (!FAST_RET) {
#pragma unroll
        for (int h = 0; h < 4; ++h) { const float q = p[C_RQ + h * 64 + lane], k = p[C_RK + h * 64 + lane];
            RQ[(size_t)tok * 256 + h * 64 + lane] = ROPE(q); RK[(size_t)tok * 256 + h * 64 + lane] = ROPE(k) * 0.125f; } }
#pragma unroll
        for (int h = 0; h < 8; ++h) { const float q = p[C_NQ + h * 64 + lane]; NQR[(size_t)tok * 512 + h * 64 + lane] = ROPE(q); }
#pragma unroll
        for (int h = 0; h < 2; ++h) { const float a = p[C_NKS + h * 64 + lane], b2 = p[C_NKW + h * 64 + lane];
            KSR[(size_t)tok * 128 + h * 64 + lane] = ROPE(a); KWR[(size_t)tok * 128 + h * 64 + lane] = ROPE(b2); }
#undef ROPE
        const float* cw = F.in[6] + (size_t)l * 3 * 256;
        if (!FAST_RET)
#pragma unroll
        for (int i = 0; i < 4; ++i) { const int ch = lane + 64 * i;
            const float u0 = p[C_CC + ch] * p[C_CH + ch];
            const float u1 = t >= 1 ? (p - PLD)[C_CC + ch] * (p - PLD)[C_CH + ch] : 0.f;
            const float u2 = t >= 2 ? (p - 2 * PLD)[C_CC + ch] * (p - 2 * PLD)[C_CH + ch] : 0.f;
            const float yv = cw[ch] * u2 + cw[256 + ch] * u1 + cw[512 + ch] * u0;
            const float o = p[C_CB + ch] * yv;
            const float on = __shfl_down(o, 1);
            if ((lane & 1) == 0) *(unsigned*)(Y + (size_t)tok * D + 256 + ch) = cvt_pk_bf16(o, on); }
    }
    LAS float* sc = (LAS float*)(F.lds + F.wave * 16384);
    LAS float* xs = sc; LAS float* hs = sc + 3072;
    for (int unit = gw; unit < 2 * NB * 2 * 64; unit += NGW) {
        const int cp = unit & 63, kvh = (unit >> 6) & 1, b = (unit >> 7) & 7, which = unit >> 10;
        const int c = 2 * cp, col = (which ? C_NVC : C_NKC) + kvh * 64;
        for (int tt = 0; tt < 48; ++tt) { const int tp = 16 * c + tt; xs[tt * 64 + lane] = tp < S ? PROJ[((size_t)b * S + tp) * PLD + col + lane] : 0.f; }
        const float* pos = F.in[7] + ((size_t)l * 2 + which) * 2048;
        const float* w1 = F.in[8] + ((size_t)l * 2 + which) * 2048 * 128;
        const float* w2 = F.in[9] + ((size_t)l * 2 + which) * 128 * 64;
        float a00 = 0.f, a01 = 0.f, a10 = 0.f, a11 = 0.f;
#pragma unroll 4
        for (int k = 0; k < 2048; ++k) { const float pv = pos[k], wa = w1[(size_t)k * 128 + lane], wb = w1[(size_t)k * 128 + 64 + lane];
            const float x0 = xs[k] + pv, x1 = xs[1024 + k] + pv;
            a00 += x0 * wa; a01 += x0 * wb; a10 += x1 * wa; a11 += x1 * wb; }
#define GELU_T(x) (0.5f * (x) * (1.f + tanhf(0.7978845608028654f * ((x) + 0.044715f * (x) * (x) * (x)))))
        hs[lane] = GELU_T(a00); hs[64 + lane] = GELU_T(a01); hs[128 + lane] = GELU_T(a10); hs[192 + lane] = GELU_T(a11);
#undef GELU_T
        float o0 = 0.f, o1 = 0.f;
        for (int n = 0; n < 128; ++n) { const float wv = w2[n * 64 + lane]; o0 += hs[n] * wv; o1 += hs[128 + n] * wv; }
        float* dst = (float*)(F.ws + (which ? WS_VC : WS_KC));
        dst[(((size_t)b * 128 + c) * 2 + kvh) * 64 + lane] = o0;
        if (c + 1 < 127) dst[(((size_t)b * 128 + c + 1) * 2 + kvh) * 64 + lane] = o1;
        LDS_WAIT();
    }
}

__device__ __forceinline__ void phase_mix(const Frame& F, int l) {
    const int gw = F.bid * NWAVES + F.wave, NGW = F.G * NWAVES, lane = F.lane;
    const float* PROJ = (const float*)(F.ws + WS_PROJ);
    bf16* Y = (bf16*)(F.ws + WS_Y);
    LAS float* sc = (LAS float*)(F.lds + F.wave * 16384);
    if (FAST_RET && FAST_NSA) {
        const int cls = F.bid % 3;
        if (cls == 0) fp8_convert_range(F, l, CONV_SPLIT + F.bid, F.G, CONV_ITEMS);
        for (int u = F.bid; u < NB * 4 * 16; u += F.G) ret_out_unit(F, l, u);
        __syncthreads();
        { const int p = F.bid; if (p < 512) { const int plane = (p & 255) >> 4, pi = p & 15; nsa_unit(launder(F), plane, p < 256 ? pi : 31 - pi); } }
        if (cls == 1) fp8_convert_range(F, l, CONV_SPLIT + F.bid, F.G, CONV_ITEMS);
        for (int p = F.bid + F.G; p < 512; p += F.G) { const int plane = (p & 255) >> 4, pi = p & 15; nsa_unit(launder(F), plane, p < 256 ? pi : 31 - pi); }
        if (cls == 2) fp8_convert_range(F, l, CONV_SPLIT + F.bid, F.G, CONV_ITEMS);
        return;
    }
    if (FAST_RET) { for (int u = F.bid; u < NB * 4 * 16; u += F.G) ret_out_unit(F, l, u); __syncthreads(); }
    if (!FAST_RET) {
        const float* RQ = (const float*)(F.ws + WS_RQ); const float* RK = (const float*)(F.ws + WS_RK);
        LAS float* qs = sc; LAS float* wb = sc + 64;
        for (int unit = gw; unit < T * 4; unit += NGW) {
            const int h = unit & 3, tok = unit >> 2, b = tok >> 11, t = tok & (S - 1);
            const float lg = c_log_gamma[h];
            qs[lane] = RQ[(size_t)tok * 256 + h * 64 + lane];
            float o = 0.f;
            for (int s0 = 0; s0 <= t; s0 += 64) {
                const int s = s0 + lane; float w = 0.f;
                if (s <= t) { const float* kr = RK + ((size_t)b * S + s) * 256 + h * 64; float dsum = 0.f;
#pragma unroll
                    for (int d = 0; d < 64; d += 4) dsum += dot4(*(const f32x4*)(kr + d), *(const LAS f32x4*)(qs + d));
                    w = dsum * expf((float)(t - s) * lg); }
                wb[lane] = w;
                const int nk = min(64, t - s0 + 1);
                const float* vp = PROJ + ((size_t)b * S + s0) * PLD + C_RV + h * 64 + lane;
                for (int k = 0; k < nk; ++k) o += wb[k] * vp[(size_t)k * PLD];
            }
            const float mean = wsum(o) * (1.f / 64.f); const float dv = o - mean; const float var = wsum(dv * dv) * (1.f / 64.f);
            float yv = dv * (1.f / sqrtf(var + LN_EPS)) * F.in[5][l * 256 + h * 64 + lane];
            const float rg = PROJ[(size_t)tok * PLD + C_RG + h * 64 + lane];
            yv *= rg * sigmoidf_(rg);
            const float yn = __shfl_down(yv, 1);
            if ((lane & 1) == 0) *(unsigned*)(Y + (size_t)tok * D + h * 64 + lane) = cvt_pk_bf16(yv, yn);
            LDS_WAIT();
        }
    }
    if (FAST_NSA) { for (int p = F.bid; p < 512; p += F.G) { const int plane = (p & 255) >> 4, pi = p & 15; nsa_unit(launder(F), plane, p < 256 ? pi : 31 - pi); } }
    if (!FAST_NSA) {
        const float* NQR = (const float*)(F.ws + WS_NQR); const float* KSR = (const float*)(F.ws + WS_KSR); const float* KWR = (const float*)(F.ws + WS_KWR);
        const float* KC = (const float*)(F.ws + WS_KC); const float* VC = (const float*)(F.ws + WS_VC);
        LAS float* qs = sc; LAS float* qr = sc + 256; LAS float* pc = sc + 512; LAS float* ps = sc + 1024; LAS float* pw = sc + 1152;
        for (int unit = gw; unit < T * 2; unit += NGW) {
            const int kvh = unit & 1, tok = unit >> 1, b = tok >> 11, t = tok & (S - 1), cur = t >> 6;
            const float* prow = PROJ + (size_t)tok * PLD;
            const float* pb = PROJ + (size_t)b * S * PLD;
#pragma unroll
            for (int g = 0; g < 4; ++g) { qs[g * 64 + lane] = prow[C_NQ + (kvh * 4 + g) * 64 + lane]; qr[g * 64 + lane] = NQR[(size_t)tok * 512 + (kvh * 4 + g) * 64 + lane]; }
            const int c0 = lane, c1 = lane + 64;
            const bool v0 = (16 * c0 + 31 <= t), v1 = (c1 < 127) && (16 * c1 + 31 <= t);
            float s0[4], s1[4];
#pragma unroll
            for (int g = 0; g < 4; ++g) { s0[g] = 0.f; s1[g] = 0.f; }
            { const float* k0p = KC + (((size_t)b * 128 + c0) * 2 + kvh) * 64; const float* k1p = KC + (((size_t)b * 128 + c1) * 2 + kvh) * 64;
#pragma unroll 4
              for (int d = 0; d < 64; d += 4) { const f32x4 ka = *(const f32x4*)(k0p + d), kb = *(const f32x4*)(k1p + d);
#pragma unroll
                  for (int g = 0; g < 4; ++g) { const f32x4 q4 = *(const LAS f32x4*)(qs + g * 64 + d); s0[g] += dot4(ka, q4); s1[g] += dot4(kb, q4); } } }
            float psum0 = 0.f, psum1 = 0.f;
#pragma unroll
            for (int g = 0; g < 4; ++g) {
                const float a0 = v0 ? s0[g] * 0.125f : -1e30f, a1 = v1 ? s1[g] * 0.125f : -1e30f;
                const float m = wmaxf(fmaxf(a0, a1));
                const float e0 = v0 ? expf(a0 - m) : 0.f, e1 = v1 ? expf(a1 - m) : 0.f;
                const float sm = wsum(e0 + e1); const float inv = sm > 0.f ? 1.f / sm : 0.f;
                const float p0 = e0 * inv, p1 = e1 * inv;
                pc[g * 128 + c0] = p0; pc[g * 128 + c1] = p1; psum0 += p0; psum1 += p1;
            }
            ps[c0] = psum0; ps[c1] = psum1;
            LDS_WAIT();
            float oc[4] = {0.f, 0.f, 0.f, 0.f};
            const int ncv = t >= 31 ? min(127, (t - 31) / 16 + 1) : 0;
            for (int c = 0; c < ncv; ++c) { const float vv = VC[(((size_t)b * 128 + c) * 2 + kvh) * 64 + lane];
#pragma unroll
                for (int g = 0; g < 4; ++g) oc[g] += pc[g * 128 + c] * vv; }
            float imp = -3.0e38f; int idx = lane;
            if (lane < 32) { float a = 0.f;
#pragma unroll
                for (int q = -1; q <= 3; ++q) { const int cc = 4 * lane + q; if (cc >= 0 && cc < 127) a += ps[cc]; }
                imp = (lane == 0 || lane == cur) ? 1e9f : (lane <= cur ? a : -1e9f); }
            int sel[8];
#pragma unroll
            for (int r = 0; r < 8; ++r) { float bv = imp; int bi = idx; wargmax(bv, bi); sel[r] = bi; if (lane == bi) imp = -INFINITY; }
            float os[4] = {0.f, 0.f, 0.f, 0.f}, ow[4] = {0.f, 0.f, 0.f, 0.f};
            {
                float ss[8][4];
#pragma unroll
                for (int r = 0; r < 8; ++r) { const int blk = sel[r], key = blk * 64 + lane; const bool ok = (blk <= cur) && (key <= t);
                    float d0 = 0.f, d1 = 0.f, d2 = 0.f, d3 = 0.f;
                    if (blk <= cur) { const float* kr = KSR + ((size_t)b * S + key) * 128 + kvh * 64;
#pragma unroll 4
                        for (int d = 0; d < 64; d += 4) { const f32x4 kv = *(const f32x4*)(kr + d);
                            d0 += dot4(kv, *(const LAS f32x4*)(qr + d)); d1 += dot4(kv, *(const LAS f32x4*)(qr + 64 + d)); d2 += dot4(kv, *(const LAS f32x4*)(qr + 128 + d)); d3 += dot4(kv, *(const LAS f32x4*)(qr + 192 + d)); } }
                    ss[r][0] = ok ? d0 * 0.125f : -1e30f; ss[r][1] = ok ? d1 * 0.125f : -1e30f; ss[r][2] = ok ? d2 * 0.125f : -1e30f; ss[r][3] = ok ? d3 * 0.125f : -1e30f; }
#pragma unroll
                for (int g = 0; g < 4; ++g) { float m = ss[0][g];
#pragma unroll
                    for (int r = 1; r < 8; ++r) m = fmaxf(m, ss[r][g]);
                    m = wmaxf(m); float es = 0.f; float ev[8];
#pragma unroll
                    for (int r = 0; r < 8; ++r) { ev[r] = ss[r][g] > -1e29f ? expf(ss[r][g] - m) : 0.f; es += ev[r]; }
                    es = wsum(es); const float inv = 1.f / es;
#pragma unroll
                    for (int r = 0; r < 8; ++r) pw[g * 512 + r * 64 + lane] = ev[r] * inv; }
                LDS_WAIT();
#pragma unroll
                for (int r = 0; r < 8; ++r) { const int blk = sel[r]; if (blk > cur) continue;
                    const int nk = min(64, t - blk * 64 + 1);
                    const float* vp = pb + (size_t)(blk * 64) * PLD + C_NVS + kvh * 64 + lane;
                    for (int k = 0; k < nk; ++k) { const float vv = vp[(size_t)k * PLD];
#pragma unroll
                        for (int g = 0; g < 4; ++g) os[g] += pw[g * 512 + r * 64 + k] * vv; } }
                LDS_WAIT();
            }
            {
                float ss[8][4];
#pragma unroll
                for (int r = 0; r < 8; ++r) { const int key = t - 511 + r * 64 + lane; const bool ok = key >= 0;
                    float d0 = 0.f, d1 = 0.f, d2 = 0.f, d3 = 0.f;
                    if (ok) { const float* kr = KWR + ((size_t)b * S + key) * 128 + kvh * 64;
#pragma unroll 4
                        for (int d = 0; d < 64; d += 4) { const f32x4 kv = *(const f32x4*)(kr + d);
                            d0 += dot4(kv, *(const LAS f32x4*)(qr + d)); d1 += dot4(kv, *(const LAS f32x4*)(qr + 64 + d)); d2 += dot4(kv, *(const LAS f32x4*)(qr + 128 + d)); d3 += dot4(kv, *(const LAS f32x4*)(qr + 192 + d)); } }
                    ss[r][0] = ok ? d0 * 0.125f : -1e30f; ss[r][1] = ok ? d1 * 0.125f : -1e30f; ss[r][2] = ok ? d2 * 0.125f : -1e30f; ss[r][3] = ok ? d3 * 0.125f : -1e30f; }
#pragma unroll
                for (int g = 0; g < 4; ++g) { float m = ss[0][g];
#pragma unroll
                    for (int r = 1; r < 8; ++r) m = fmaxf(m, ss[r][g]);
                    m = wmaxf(m); float es = 0.f; float ev[8];
#pragma unroll
                    for (int r = 0; r < 8; ++r) { ev[r] = ss[r][g] > -1e29f ? expf(ss[r][g] - m) : 0.f; es += ev[r]; }
                    es = wsum(es); const float inv = 1.f / es;
#pragma unroll
                    for (int r = 0; r < 8; ++r) pw[g * 512 + r * 64 + lane] = ev[r] * inv; }
                LDS_WAIT();
                const int k0 = max(0, t - 511);
                const float* vp = pb + C_NVW + kvh * 64 + lane;
                for (int key = k0; key <= t; ++key) { const float vv = vp[(size_t)key * PLD]; const int pi = key - (t - 511);
#pragma unroll
                    for (int g = 0; g < 4; ++g) ow[g] += pw[g * 512 + pi] * vv; }
                LDS_WAIT();
            }
#pragma unroll
            for (int g = 0; g < 4; ++g) { const int head = kvh * 4 + g;
                const float g0 = sigmoidf_(prow[C_NG + head * 3 + 0]), g1 = sigmoidf_(prow[C_NG + head * 3 + 1]), g2 = sigmoidf_(prow[C_NG + head * 3 + 2]);
                const float o = g0 * oc[g] + g1 * os[g] + g2 * ow[g];
                const float on = __shfl_down(o, 1);
                if ((lane & 1) == 0) *(unsigned*)(Y + (size_t)tok * D + 512 + head * 64 + lane) = cvt_pk_bf16(o, on); }
        }
    }
}

constexpr int NPH_LAYER = 8, NPHASES = 2 + DEPTH * NPH_LAYER;

__global__ void __launch_bounds__(NTHR, 2) fwd(Args args) {
    extern __shared__ __attribute__((aligned(16))) unsigned char lds_raw[];
    Frame F;
    F.lds = (LAS unsigned char*)lds_raw; F.ws = (GAS unsigned char*)args.ws; F.out = (GAS float*)args.out; F.in = args.in;
    F.tid = threadIdx.x; F.lane = F.tid & 63; F.wave = __builtin_amdgcn_readfirstlane(F.tid >> 6); F.bid = blockIdx.x; F.G = gridDim.x;
    const bool is_t0 = (F.tid == 0);
    volatile LAS unsigned* MISC = (volatile LAS unsigned*)(F.lds + LDS_MISC);
    if (F.tid < 128) MISC[F.tid] = 0u;
    __syncthreads();
    const int lo = args.ph_lo, hi = args.ph_hi;
    const bool multi = (hi - lo) > 1;
    XcdBarrier bar; bar.bar = (unsigned*)(F.ws + WS_CTL) + CW_BAR; bar.x = 0; bar.st = MISC + 8;
    if (multi) bar = xcd_barrier_post((unsigned*)(F.ws + WS_CTL) + CW_BAR, MISC + 8, is_t0);
#ifndef PMASK
#define PMASK 0xFFFF
#endif
#ifndef REPMASK
#define REPMASK 0
#endif
#define REPS(b) (((REPMASK) & (b)) ? 2 : 1)
#define IN(k) (lo <= (k) && (k) < hi)
#define SEAM(k) do { if (IN(k) && IN((k) + 1)) xcd_barrier(bar, is_t0); } while (0)
    if ((PMASK & 1) && IN(0)) { for (int rep = 0; rep < REPS(1); ++rep) { F = launder(F); phase_p0(F); } SEAM(0); }
    if ((PMASK & 2) && IN(1)) { F = launder(F); phase_row<0>(F, 0); SEAM(1); }
    for (int l = 0; l < DEPTH; ++l) {
        const int pb = 2 + l * NPH_LAYER;
        if ((PMASK & 4) && IN(pb + 0)) { for (int rep = 0; rep < REPS(4); ++rep) { F = launder(F); phase_gemm_in(F, l); if (REPS(4) > 1) __syncthreads(); } SEAM(pb + 0); }
        if ((PMASK & 8) && IN(pb + 1)) { for (int rep = 0; rep < REPS(8); ++rep) { F = launder(F); phase_prep(F, l); if (REPS(8) > 1) __syncthreads(); } SEAM(pb + 1); }
        if ((PMASK & 16) && IN(pb + 2)) { for (int rep = 0; rep < REPS(16); ++rep) { F = launder(F); phase_mix(F, l); if (REPS(16) > 1) __syncthreads(); } SEAM(pb + 2); }
        if ((PMASK & 32) && IN(pb + 3)) { for (int rep = 0; rep < REPS(32); ++rep) { F = launder(F); phase_gemm_out(F, l); if (REPS(32) > 1) __syncthreads(); } SEAM(pb + 3); }
        if ((PMASK & 64) && IN(pb + 4)) { for (int rep = 0; rep < REPS(64); ++rep) { F = launder(F); phase_row1(F, l); if (REPS(64) > 1) __syncthreads(); } SEAM(pb + 4); }
        if ((PMASK & 128) && IN(pb + 5)) { for (int rep = 0; rep < REPS(128); ++rep) { F = launder(F); phase_moe<0>(F, l); if (REPS(128) > 1) __syncthreads(); } SEAM(pb + 5); }
        if ((PMASK & 256) && IN(pb + 6)) { for (int rep = 0; rep < REPS(256); ++rep) { F = launder(F); phase_moe<1>(F, l); if (REPS(256) > 1) __syncthreads(); } SEAM(pb + 6); }
        if ((PMASK & 512) && IN(pb + 7)) { for (int rep = 0; rep < REPS(512); ++rep) { F = launder(F); phase_row2(F, l); if (REPS(512) > 1) __syncthreads(); } SEAM(pb + 7); }
    }
#undef IN
#undef SEAM
}

extern "C" void kernel_launch(void* const* d_in, const int* in_sizes, int n_in, void* d_out, int out_size, void* d_ws, size_t ws_size, hipStream_t stream) {
    static int grid = 0;
    if (grid == 0) {
        if (n_in != 20 || out_size != T * D || ws_size < WS_END) { fprintf(stderr, "kernel_launch: unexpected problem (n_in %d out %d ws %zu)\n", n_in, out_size, ws_size); grid = -1; return; }
        int dev = 0, cus = 0;
        if (hipGetDevice(&dev) != hipSuccess || hipDeviceGetAttribute(&cus, hipDeviceAttributeMultiprocessorCount, dev) != hipSuccess) { grid = -1; return; }
        if (hipFuncSetAttribute((const void*)fwd, hipFuncAttributeMaxDynamicSharedMemorySize, LDS_BYTES) != hipSuccess) { fprintf(stderr, "kernel_launch: hipFuncSetAttribute failed\n"); grid = -1; return; }
        int per_cu = 0;
        if (hipOccupancyMaxActiveBlocksPerMultiprocessor(&per_cu, (const void*)fwd, NTHR, LDS_BYTES) != hipSuccess || per_cu < 1) fprintf(stderr, "kernel_launch: occupancy query says %d\n", per_cu);
        (void)hipGetLastError();
        grid = cus;
    }
    if (grid < 0) return;
    (void)hipMemsetAsync((char*)d_ws + WS_CTL, 0, CTL_BYTES, stream);
    Args a{};
    for (int i = 0; i < 20; ++i) a.in[i] = (const float*)d_in[i];
    a.out = (float*)d_out; a.ws = (unsigned char*)d_ws;
#if ONE_LAUNCH
    a.ph_lo = 0; a.ph_hi = NPHASES;
    hipLaunchKernelGGL(fwd, dim3(grid), dim3(NTHR), LDS_BYTES, stream, a);
#else
    for (int p = 0; p < NPHASES; ++p) { a.ph_lo = p; a.ph_hi = p + 1; hipLaunchKernelGGL(fwd, dim3(grid), dim3(NTHR), LDS_BYTES, stream, a); }
#endif
}
```

```cpp
#include <hip/hip_runtime.h>
#include <cstdio>
#include <cstdint>

#ifndef ONE_LAUNCH
#define ONE_LAUNCH 1
#endif

#define LAS __attribute__((address_space(3)))
typedef unsigned short bf16;
typedef short bf16x8 __attribute__((ext_vector_type(8)));
typedef float f32x4 __attribute__((ext_vector_type(4)));
typedef unsigned u32x4 __attribute__((ext_vector_type(4)));
typedef unsigned u32x2 __attribute__((ext_vector_type(2)));

constexpr int NB = 8, S = 2048, D = 1024, T = NB * S, DEPTH = 4;
constexpr int NIN = 3096, NINP = 3104, PLD = 3200;
constexpr int C_RQ = 0, C_RK = 256, C_RV = 512, C_RG = 768, C_CB = 1024, C_CC = 1280, C_CH = 1536, C_NQ = 1792,
              C_NKC = 2304, C_NVC = 2432, C_NKS = 2560, C_NVS = 2688, C_NKW = 2816, C_NVW = 2944, C_NG = 3072;
constexpr int NE = 32, TOPK = 4, FF = 1024;
constexpr float ALPHA = 1.681792830507429f, LN_EPS = 1e-5f;
constexpr int NWAVES = 8, NTHR = 512;

constexpr size_t MiB = 1u << 20;
constexpr size_t WS_CTL = 0, CTL_BYTES = 1 * MiB;
constexpr size_t WS_MOD = 1 * MiB;
constexpr size_t WS_ROPEC = 2 * MiB, WS_ROPES = 4 * MiB;
constexpr size_t WS_KC = 6 * MiB, WS_VC = 6 * MiB + 512 * 1024;
constexpr size_t WS_GATEW = 7 * MiB;
constexpr size_t WS_LIST = 8 * MiB;
constexpr size_t WS_WOUT = 16 * MiB;
constexpr size_t WS_WIN = 24 * MiB;
constexpr size_t WS_H = 64 * MiB;
constexpr size_t WS_Y = 96 * MiB;
constexpr size_t WS_MIX = 128 * MiB;
constexpr size_t WS_RQ = 192 * MiB, WS_RK = 208 * MiB;
constexpr size_t WS_NQR = 224 * MiB;
constexpr size_t WS_KSR = 256 * MiB, WS_KWR = 264 * MiB;
constexpr size_t WS_PROJ = 272 * MiB;
constexpr size_t WS_XB = 336 * MiB;
constexpr size_t WS_ACT = 480 * MiB;
constexpr size_t WS_YK = 640 * MiB;
constexpr size_t WS_WGU = 896 * MiB;
constexpr size_t WS_WDN = 1408 * MiB;
constexpr size_t WS_PRQ = 1664 * MiB, WS_PRK = 1672 * MiB, WS_PRV = 1680 * MiB;
constexpr size_t WS_RG = 1688 * MiB;
constexpr size_t WS_CV = 1696 * MiB;
constexpr size_t WS_NQU = 1720 * MiB, WS_NQRB = 1736 * MiB;
constexpr size_t WS_NKC = 1752 * MiB, WS_NVC = 1756 * MiB, WS_NKS = 1760 * MiB, WS_NVST = 1764 * MiB, WS_NKW = 1768 * MiB, WS_NVWT = 1772 * MiB;
constexpr size_t WS_NG = 1776 * MiB;
constexpr size_t WS_KVB = 1780 * MiB;
constexpr size_t WS_KCB = 1788 * MiB, WS_VCT = 1789 * MiB;
constexpr size_t WS_CW1T = 1790 * MiB, WS_CW2T = 1794 * MiB, WS_CB1 = 1795 * MiB;
constexpr size_t WS_RWT = 1796 * MiB;
constexpr size_t WS_END = 1800 * MiB;
constexpr size_t WS_HQ = 192 * MiB;
constexpr size_t WS_HS = 208 * MiB;
constexpr size_t WS_LHS = 210 * MiB, WS_LGW = 212 * MiB;
constexpr int CW_WMAX = 2048;
constexpr float NSA_QS = 0.125f * 1.4426950408889634f;
constexpr float ACT_QS = 8.f;
constexpr bool FAST_RET = true, FAST_NSA = true;
constexpr bool KEEP_PROJ = !FAST_NSA;
constexpr int CW_CNT = 1024;
constexpr int CW_BAR = 4096;

constexpr int LDS_MISC = 131072;
constexpr int LDS_BYTES = 147456;

#define XB_TMO      128
#define XB_XCNT(j)  (256  + 64 * (j))
#define XB_XSUB(j)  (1280 + 64 * (j))
#define XB_XGEN(j)  (2304 + 64 * (j))
#define XB_TOP      3328
#define XB_TOPGEN   3392
#define XCD_BAR_WORDS 3456
#define XB_SPIN_CAP (1u << 18)
__device__ __forceinline__ unsigned xb_ld(unsigned* p)              { return __hip_atomic_load(p, __ATOMIC_RELAXED, __HIP_MEMORY_SCOPE_AGENT); }
__device__ __forceinline__ unsigned xb_add(unsigned* p, unsigned v) { return __hip_atomic_fetch_add(p, v, __ATOMIC_RELAXED, __HIP_MEMORY_SCOPE_AGENT); }
__device__ __forceinline__ unsigned xb_xcc_id() { return (unsigned)__builtin_amdgcn_s_getreg((3 << 11) | 20) & 0xFu; }
#define XB_SPIN(cond, bar) do { unsigned _sp = 0; while (cond) { __builtin_amdgcn_s_sleep(1); \
    if ((++_sp & 255u) == 0u) { if (xb_ld(&(bar)[XB_TMO])) break; if (_sp > XB_SPIN_CAP) { atomicAdd(&(bar)[XB_TMO], 1u); break; } } } } while (0)
struct XcdBarrier { unsigned* bar; unsigned x; volatile LAS unsigned* st; };
__device__ __forceinline__ XcdBarrier xcd_barrier_post(unsigned* bar, volatile LAS unsigned* st, const bool is_t0) {
    XcdBarrier b; b.bar = bar; b.x = xb_xcc_id(); b.st = st;
    if (is_t0) (void)xb_add(&bar[XB_XCNT(b.x)], 1u);
    return b;
}
__device__ __forceinline__ void xcd_barrier_complete(unsigned* bar, unsigned x, unsigned& nloc, unsigned& nx) {
    const unsigned G = gridDim.x * gridDim.y * gridDim.z;
    unsigned sum, cnt, mine, sp = 0u;
    for (;;) {
        sum = 0u; cnt = 0u; mine = 0u;
#pragma unroll
        for (unsigned j = 0; j < 16; ++j) { const unsigned c = xb_ld(&bar[XB_XCNT(j)]); sum += c; cnt += (c > 0u) ? 1u : 0u; mine = (j == x) ? c : mine; }
        if (sum == G) break;
        __builtin_amdgcn_s_sleep(1);
        if ((++sp & 255u) == 0u) { if (xb_ld(&bar[XB_TMO])) break; if (sp > XB_SPIN_CAP) { atomicAdd(&bar[XB_TMO], 1u); break; } }
    }
    nloc = mine > 0u ? mine : 1u; nx = cnt > 0u ? cnt : 1u;
}
__device__ __forceinline__ void xcd_barrier(const XcdBarrier& b, const bool is_t0) {
    asm volatile("s_waitcnt vmcnt(0)" ::: "memory");
    __syncthreads();
    if (is_t0) {
        unsigned* bar = b.bar;
        __builtin_amdgcn_s_waitcnt(0);
        unsigned nloc = b.st[0], nx = b.st[1];
        if (nloc == 0u) { xcd_barrier_complete(bar, b.x, nloc, nx); b.st[0] = nloc; b.st[1] = nx; }
        const unsigned old = xb_add(&bar[XB_XSUB(b.x)], 1u);
        const unsigned gen = old / nloc;
        if (old + 1u == (gen + 1u) * nloc) {
            __builtin_amdgcn_fence(__ATOMIC_RELEASE, "agent");
            asm volatile("s_waitcnt vmcnt(0)" ::: "memory");
            const unsigned og = xb_add(&bar[XB_TOP], 1u);
            const unsigned tg = og / nx;
            if (og + 1u == (tg + 1u) * nx) xb_add(&bar[XB_TOPGEN], 1u);
            else XB_SPIN(xb_ld(&bar[XB_TOPGEN]) == tg, bar);
            __builtin_amdgcn_fence(__ATOMIC_ACQUIRE, "agent");
            xb_add(&bar[XB_XGEN(b.x)], 1u);
            asm volatile("s_waitcnt vmcnt(0)" ::: "memory");
        } else {
            XB_SPIN(xb_ld(&bar[XB_XGEN(b.x)]) == gen, bar);
            __builtin_amdgcn_fence(__ATOMIC_ACQUIRE, "agent");
            asm volatile("s_waitcnt vmcnt(0)" ::: "memory");
        }
    }
    __syncthreads();
}

#define LDS_WAIT() asm volatile("s_waitcnt lgkmcnt(0)" ::: "memory")
#define LDS_BARRIER() do { asm volatile("s_waitcnt lgkmcnt(0)" ::: "memory"); __builtin_amdgcn_s_barrier(); asm volatile("" ::: "memory"); } while (0)
__device__ __forceinline__ unsigned cvt_pk_bf16(float lo, float hi) { unsigned r; asm("v_cvt_pk_bf16_f32 %0, %1, %2" : "=v"(r) : "v"(lo), "v"(hi)); return r; }
__device__ __forceinline__ float wsum(float v) {
#pragma unroll
    for (int o = 32; o >= 1; o >>= 1) v += __shfl_xor(v, o);
    return v;
}
__device__ __forceinline__ float wmaxf(float v) {
#pragma unroll
    for (int o = 32; o >= 1; o >>= 1) v = fmaxf(v, __shfl_xor(v, o));
    return v;
}
__device__ __forceinline__ void wargmax(float& v, int& i) {
#pragma unroll
    for (int o = 32; o >= 1; o >>= 1) {
        const float ov = __shfl_xor(v, o); const int oi = __shfl_xor(i, o);
        const bool take = (ov > v) || (ov == v && oi < i);
        v = take ? ov : v; i = take ? oi : i;
    }
}
__device__ __forceinline__ float w_qscale(float wmax) { return exp2f(floorf(log2f(128.f / fmaxf(wmax, 1e-30f)))); }
__device__ __forceinline__ unsigned pk4_fp8(f32x4 v) { int r = 0; r = __builtin_amdgcn_cvt_pk_fp8_f32(v.x, v.y, r, false); r = __builtin_amdgcn_cvt_pk_fp8_f32(v.z, v.w, r, true); return (unsigned)r; }
__device__ __forceinline__ float dot4(f32x4 a, f32x4 b) { return a.x * b.x + a.y * b.y + a.z * b.z + a.w * b.w; }
__device__ __forceinline__ float sigmoidf_(float x) { return 1.f / (1.f + expf(-x)); }

struct Args { const float* in[20]; float* out; unsigned char* ws; int ph_lo, ph_hi; };
#define GAS __attribute__((address_space(1)))
struct Frame {
    LAS unsigned char* lds;
    GAS unsigned char* ws;
    const float* const* in;
    GAS float* out;
    int tid, lane, wave, bid, G;
};

__device__ __forceinline__ int hw_lane() { return (int)__builtin_amdgcn_mbcnt_hi(~0u, __builtin_amdgcn_mbcnt_lo(~0u, 0u)); }
__device__ __forceinline__ Frame launder(const Frame& F) {
    Frame G = F;
    asm volatile("" : "+v"(G.tid));
    G.lane = G.tid & 63; G.wave = __builtin_amdgcn_readfirstlane(G.tid >> 6);
    asm volatile("" : "+s"(G.ws), "+s"(G.out));

    return G;
}
__constant__ double c_inv_freq[32] = {
    1.0, 0.7498942093324559, 0.5623413251903491, 0.4216965034285822,
    0.31622776601683794, 0.23713737056616552, 0.1778279410038923, 0.1333521432163324,
    0.1, 0.07498942093324558, 0.05623413251903491, 0.042169650342858224,
    0.03162277660168379, 0.023713737056616554, 0.01778279410038923, 0.01333521432163324,
    0.01, 0.007498942093324558, 0.005623413251903491, 0.004216965034285823,
    0.0031622776601683794, 0.0023713737056616554, 0.0017782794100389228, 0.001333521432163324,
    0.001, 0.0007498942093324559, 0.0005623413251903491, 0.00042169650342858224,
    0.00031622776601683794, 0.00023713737056616554, 0.00017782794100389227, 0.0001333521432163324};

__device__ __forceinline__ int perm32s(int c) { return (c & ~31) + (((c >> 2) & 1) << 4) + (((c & 31) >> 3) << 2) + (c & 3); }
template <int MAP> __device__ __forceinline__ int map_row(int n) {
    if (MAP == 0) return n;
    if (MAP == 3) return perm32s(n);
    if (MAP == 1) { const int half = n >> 10, j = n & 1023; return ((j >> 7) << 8) + (half << 7) + perm32s(j & 127); }
    if (n >= 3072) return n;
    const int w = n & 255; return (n & ~255) + (((w >> 5) & 1) << 7) + ((w >> 6) << 5) + perm32s(w & 31);
}
typedef float f32x2 __attribute__((ext_vector_type(2)));
struct TItem { const float* W; bf16* WT; int K, N, Npad, map, k0, n0; };
__device__ __forceinline__ int map_row_rt(int map, int n) { return map == 0 ? n : (map == 1 ? map_row<1>(n) : (map == 3 ? map_row<3>(n) : map_row<2>(n))); }
__device__ __forceinline__ bool titem_decode(const Frame& F, int it, TItem& t) {
    constexpr int B_IN = (NINP + 63) / 64, I_IN = 16 * B_IN, I_OUT = 16 * 16, I_GU = 16 * 32, I_DN = 16 * 16, I_C1 = 32 * 2, I_C2 = 2 * 1;
    constexpr int N_IN = DEPTH * I_IN, N_OUT = DEPTH * I_OUT, N_GU = DEPTH * NE * I_GU, N_DN = DEPTH * NE * I_DN, N_C1 = 8 * I_C1, N_C2 = 8 * I_C2;
    int r = it, nblk, item;
    if (r < N_IN) { const int l = r / I_IN; t.W = F.in[3] + (size_t)l * D * NIN; t.WT = (bf16*)(F.ws + WS_WIN) + (size_t)l * NINP * D; t.K = D; t.N = NIN; t.Npad = NINP; t.map = 2; nblk = B_IN; item = r % I_IN; }
    else if ((r -= N_IN) < N_OUT) { const int l = r / I_OUT; t.W = F.in[4] + (size_t)l * D * D; t.WT = (bf16*)(F.ws + WS_WOUT) + (size_t)l * D * D; t.K = D; t.N = D; t.Npad = D; t.map = 3; nblk = 16; item = r % I_OUT; }
    else if ((r -= N_OUT) < N_C1) { const int lw = r / I_C1; t.W = F.in[8] + (size_t)lw * 2048 * 128; t.WT = (bf16*)(F.ws + WS_CW1T) + (size_t)lw * 128 * 2048; t.K = 2048; t.N = 128; t.Npad = 128; t.map = 0; nblk = 2; item = r % I_C1; }
    else if ((r -= N_C1) < N_C2) { const int lw = r / I_C2; t.W = F.in[9] + (size_t)lw * 128 * 64; t.WT = (bf16*)(F.ws + WS_CW2T) + (size_t)lw * 64 * 128; t.K = 128; t.N = 64; t.Npad = 64; t.map = 0; nblk = 1; item = r % I_C2; }
    else return false;
    t.k0 = 64 * (item / nblk); t.n0 = 64 * (item % nblk); return true;
}
__device__ __forceinline__ void titem_load(const TItem& t, int lane, f32x2 (&v)[32]) {
    const int nn = t.n0 + 2 * (lane & 31);
    const float* wp = t.W + (size_t)(t.k0 + (lane >> 5)) * t.N + (nn < t.N ? nn : 0);
#pragma unroll
    for (int q = 0; q < 32; ++q) v[q] = __builtin_nontemporal_load((const f32x2*)(wp + (size_t)(2 * q) * t.N));
}
__device__ __forceinline__ void titem_store(const TItem& t, int lane, const f32x2 (&v)[32], LAS unsigned* scr) {
    const int np = lane & 31; const bool inb = t.n0 + 2 * np < t.N;
#pragma unroll
    for (int q = 0; q < 32; ++q) scr[(2 * q + (lane >> 5)) * 33 + np] = inb ? cvt_pk_bf16(v[q].x, v[q].y) : 0u;
    LDS_WAIT();
    const int c = lane & 7;
#pragma unroll
    for (int j = 0; j < 8; ++j) { const int n = 8 * j + (lane >> 3); const LAS unsigned* sp = scr + (8 * c) * 33 + (n >> 1); const int sh = (n & 1) * 16;
        unsigned e[8];
#pragma unroll
        for (int i = 0; i < 8; ++i) e[i] = (sp[i * 33] >> sh) & 0xffffu;
        u32x4 o; o.x = e[0] | (e[1] << 16); o.y = e[2] | (e[3] << 16); o.z = e[4] | (e[5] << 16); o.w = e[6] | (e[7] << 16);
        if (t.n0 + n < t.Npad) *(u32x4*)(t.WT + (size_t)map_row_rt(t.map, t.n0 + n) * t.K + t.k0 + 8 * c) = o; }
    LDS_WAIT();
}

struct TItem8 { const float* W; unsigned char* WT; int N, map, k0, n0; float scale; };
__device__ __forceinline__ bool titem8_decode(const Frame& F, int l, int it, TItem8& t) {
    constexpr int I_GU = 8 * 64, I_DN = 8 * 32, N_GU = NE * I_GU, N_DN = NE * I_DN;
    const float* wmax = (const float*)((const unsigned*)(F.ws + WS_CTL) + CW_WMAX);
    int r = it, nblk, item;
    if (r < 0) return false;
    if (r < N_GU) { const int le = l * NE + r / I_GU; t.W = F.in[16] + (size_t)le * D * 2048; t.WT = (unsigned char*)(F.ws + WS_WGU) + (size_t)le * 2048 * D; t.N = 2048; t.map = 1; nblk = 64; item = r % I_GU; t.scale = w_qscale(wmax[(le >> 5) * 2 + 0]); }
    else if ((r -= N_GU) < N_DN) { const int le = l * NE + r / I_DN; t.W = F.in[18] + (size_t)le * FF * D; t.WT = (unsigned char*)(F.ws + WS_WDN) + (size_t)le * D * FF; t.N = D; t.map = 3; nblk = 32; item = r % I_DN; t.scale = w_qscale(wmax[(le >> 5) * 2 + 1]); }
    else return false;
    t.k0 = 128 * (item / nblk); t.n0 = 32 * (item % nblk); return true;
}
__device__ __forceinline__ void titem8_load(const TItem8& t, int lane, float (&v)[64]) {
    const float* wp = t.W + (size_t)(t.k0 + (lane >> 5)) * t.N + t.n0 + (lane & 31);
#pragma unroll
    for (int q = 0; q < 64; ++q) v[q] = __builtin_nontemporal_load(wp + (size_t)(2 * q) * t.N);
}
__device__ __forceinline__ void titem8_store(const TItem8& t, int lane, const float (&v)[64], LAS unsigned char* scr) {
    LAS unsigned char* rowp = scr + (lane & 31) * 132 + (lane >> 5);
#pragma unroll
    for (int q = 0; q < 64; q += 2) { const int r = __builtin_amdgcn_cvt_pk_fp8_f32(v[q] * t.scale, v[q + 1] * t.scale, 0, false);
        rowp[2 * q] = (unsigned char)(r & 0xff); rowp[2 * q + 2] = (unsigned char)((r >> 8) & 0xff); }
    LDS_WAIT();
    const int c = lane & 7;
#pragma unroll
    for (int j = 0; j < 4; ++j) { const int n = 8 * j + (lane >> 3); const LAS unsigned* sp = (const LAS unsigned*)(scr + n * 132 + 16 * c);
        u32x4 o; o.x = sp[0]; o.y = sp[1]; o.z = sp[2]; o.w = sp[3];
        *(u32x4*)(t.WT + (size_t)map_row_rt(t.map, t.n0 + n) * D + t.k0 + 16 * c) = o; }
    LDS_WAIT();
}
struct WItem { const float* W; unsigned char* WT; int N, map, k0, n0; float scale; };
__device__ __forceinline__ bool witem_decode(const Frame& F, int l, int it, WItem& t) {
    constexpr int I_GU = 4 * 16, I_DN = 4 * 8, N_GU = NE * I_GU, N_DN = NE * I_DN;
    const float* wmax = (const float*)((const unsigned*)(F.ws + WS_CTL) + CW_WMAX);
    int r = it, nblk, item;
    if (r < N_GU) { const int le = l * NE + r / I_GU; t.W = F.in[16] + (size_t)le * D * 2048; t.WT = (unsigned char*)(F.ws + WS_WGU) + (size_t)le * 2048 * D; t.N = 2048; t.map = 1; nblk = 16; item = r % I_GU; t.scale = w_qscale(wmax[l * 2 + 0]); }
    else if ((r -= N_GU) < N_DN) { const int le = l * NE + r / I_DN; t.W = F.in[18] + (size_t)le * FF * D; t.WT = (unsigned char*)(F.ws + WS_WDN) + (size_t)le * D * FF; t.N = D; t.map = 3; nblk = 8; item = r % I_DN; t.scale = w_qscale(wmax[l * 2 + 1]); }
    else return false;
    t.k0 = 256 * (item / nblk); t.n0 = 128 * (item % nblk); return true;
}
__device__ __forceinline__ void witem_load(const WItem& t, int wave, int lane, f32x4 (&v)[16]) {
    const float* wp = t.W + (size_t)(t.k0 + 32 * wave + 16 * (lane >> 5)) * t.N + t.n0 + 4 * (lane & 31);
#pragma unroll
    for (int q = 0; q < 16; ++q) v[q] = __builtin_nontemporal_load((const f32x4*)(wp + (size_t)q * t.N));
}
__device__ __forceinline__ void witem_store(const Frame& F, const WItem& t, const f32x4 (&v)[16], LAS unsigned char* tile) {
    const int i = F.lane & 31, hi = F.lane >> 5;
#pragma unroll
    for (int j = 0; j < 4; ++j) {
        u32x4 o;
#pragma unroll
        for (int d = 0; d < 4; ++d) { int r = __builtin_amdgcn_cvt_pk_fp8_f32(v[4 * d][j] * t.scale, v[4 * d + 1][j] * t.scale, 0, false);
            r = __builtin_amdgcn_cvt_pk_fp8_f32(v[4 * d + 2][j] * t.scale, v[4 * d + 3][j] * t.scale, r, true); o[d] = (unsigned)r; }
        *(LAS u32x4*)(tile + (32 * j + i) * 272 + 32 * F.wave + 16 * hi) = o;
    }
    __syncthreads();
    const int c = F.tid & 15;
#pragma unroll
    for (int pass = 0; pass < 4; ++pass) { const int n = (F.tid >> 4) + 32 * pass, rho = (n & 3) * 32 + (n >> 2);
        const u32x4 o = *(const LAS u32x4*)(tile + rho * 272 + 16 * c);
        *(u32x4*)(t.WT + (size_t)map_row_rt(t.map, t.n0 + n) * D + t.k0 + 16 * c) = o; }
}
constexpr int CONV_ITEMS = NE * (4 * 16 + 4 * 8);
constexpr int CONV_SPLIT = CONV_ITEMS / 2;
__device__ __forceinline__ void fp8_convert_range(const Frame& F, int l, int start, int stride, int limit) {
    __syncthreads();
    WItem ta, tb; f32x4 va[16], vb[16];
    int it = start;
    bool ha = it < limit && witem_decode(F, l, it, ta);
    if (ha) witem_load(ta, F.wave, F.lane, va);
    while (ha) {
        const bool hb = it + stride < limit && witem_decode(F, l, it + stride, tb);
        if (hb) witem_load(tb, F.wave, F.lane, vb);
        witem_store(F, ta, va, F.lds);
        if (!hb) break;
        it += 2 * stride;
        ha = it < limit && witem_decode(F, l, it, ta);
        if (ha) witem_load(ta, F.wave, F.lane, va);
        witem_store(F, tb, vb, F.lds + 34816);
    }
    __syncthreads();
}
__device__ __forceinline__ void sample_wmax(const Frame& F) {
    const int gw = F.bid * NWAVES + F.wave, NGW = F.G * NWAVES, lane = F.lane;
    for (int task = gw; task < 2048; task += NGW) { const int le = task >> 4, part = task & 15;
        float mg = 0.f, md = 0.f;
#pragma unroll
        for (int i = 0; i < 1; ++i) { const int k = 64 * part + 16 * i;
            const float* g = F.in[16] + ((size_t)le * D + k) * 2048 + lane * 4; const float* dn = F.in[18] + ((size_t)le * FF + k) * D + lane * 4;
#pragma unroll
            for (int j = 0; j < 8; ++j) { const f32x4 v = *(const f32x4*)(g + 256 * j); mg = fmaxf(mg, fmaxf(fmaxf(fabsf(v.x), fabsf(v.y)), fmaxf(fabsf(v.z), fabsf(v.w)))); }
#pragma unroll
            for (int j = 0; j < 4; ++j) { const f32x4 v = *(const f32x4*)(dn + 256 * j); md = fmaxf(md, fmaxf(fmaxf(fabsf(v.x), fabsf(v.y)), fmaxf(fabsf(v.z), fabsf(v.w)))); } }
        mg = wmaxf(mg); md = wmaxf(md);
        LAS float* rd = (LAS float*)F.lds;
        __syncthreads();
        if (lane == 0) { rd[F.wave * 2] = mg; rd[F.wave * 2 + 1] = md; }
        __syncthreads();
        if (F.tid < 2) { float m = 0.f;
#pragma unroll
            for (int w2 = 0; w2 < 8; ++w2) m = fmaxf(m, rd[w2 * 2 + F.tid]);
            atomicMax((unsigned*)(F.ws + WS_CTL) + CW_WMAX + (le >> 5) * 2 + F.tid, __float_as_uint(m)); }
    }
    __syncthreads();
}

__device__ __forceinline__ void phase_p0(const Frame& F) {
    sample_wmax(F);
    LAS unsigned* scr = (LAS unsigned*)(F.lds + F.wave * 16384);
    const int gw = F.bid * NWAVES + F.wave, NGW = F.G * NWAVES;
    {
        TItem ta, tb; f32x2 va[32], vb[32];
        int it = gw;
        bool ha = titem_decode(F, it, ta);
        if (ha) titem_load(ta, F.lane, va);
        while (ha) {
            const bool hb = titem_decode(F, it + NGW, tb);
            if (hb) titem_load(tb, F.lane, vb);
            titem_store(ta, F.lane, va, scr);
            if (!hb) break;
            it += 2 * NGW;
            ha = titem_decode(F, it, ta);
            if (ha) titem_load(ta, F.lane, va);
            titem_store(tb, F.lane, vb, scr);
        }
    }
    __syncthreads();
    { LAS float* red = (LAS float*)F.lds;
      for (int it = (F.G >= 256 ? F.bid - (F.G - 16) : F.bid); it >= 0 && it < 16; it += F.G) { const int lw = it >> 1, n = (it & 1) * 64 + F.lane; float a = 0.f;
        const float* pos = F.in[7] + (size_t)lw * 2048 + F.wave * 256; const float* w1 = F.in[8] + ((size_t)lw * 2048 + F.wave * 256) * 128 + n;
#pragma unroll 16
        for (int k = 0; k < 256; ++k) a += pos[k] * w1[(size_t)k * 128];
        red[F.wave * 64 + F.lane] = a;
        __syncthreads();
        if (F.wave == 0) { float sm = 0.f;
#pragma unroll
            for (int w2 = 0; w2 < 8; ++w2) sm += red[w2 * 64 + F.lane];
            ((float*)(F.ws + WS_CB1))[lw * 128 + n] = sm; }
        __syncthreads(); } }
    for (int i = F.bid * NTHR + F.tid; i < DEPTH * NE * D; i += F.G * NTHR) { const int k = i & (D - 1), e = (i >> 10) & (NE - 1), l2 = i >> 15;
        ((float*)(F.ws + WS_RWT))[i] = F.in[14][((size_t)l2 * D + k) * NE + e]; }
    for (int i = F.bid * NTHR + F.tid; i < T * 32; i += F.G * NTHR) {
        const int tok = i >> 5, f = i & 31;
        const double ang = (double)((const int*)F.in[2])[tok] * c_inv_freq[f];
        const double k = rint(ang * 0.15915494309189535);
        const float r = (float)(ang - k * 6.283185307179586);
        ((float*)(F.ws + WS_ROPEC))[i] = cosf(r); ((float*)(F.ws + WS_ROPES))[i] = sinf(r);
    }
    __syncthreads();
    LAS float* red = (LAS float*)F.lds;
    LAS float* sil = (LAS float*)(F.lds + 65536);
    for (int i = F.tid; i < NB * D; i += NTHR) { const float cv = F.in[1][i]; sil[i] = cv * sigmoidf_(cv); }
    __syncthreads();
    typedef float f32x2v __attribute__((ext_vector_type(2)));
    for (int it = F.bid; it < DEPTH * 48; it += F.G) {
        const int l = it / 48, n0 = (it % 48) * 128 + 2 * F.lane;
        f32x2v acc[8];
#pragma unroll
        for (int b = 0; b < 8; ++b) acc[b] = (f32x2v){0.f, 0.f};
        const float* w = F.in[10] + (size_t)l * D * 6144 + n0;
        for (int k0 = F.wave * 128; k0 < F.wave * 128 + 128; k0 += 16) {
            f32x2v wv[16];
#pragma unroll
            for (int q = 0; q < 16; ++q) wv[q] = __builtin_nontemporal_load((const f32x2v*)(w + (size_t)(k0 + q) * 6144));
#pragma unroll
            for (int q = 0; q < 16; ++q)
#pragma unroll
                for (int b = 0; b < 8; ++b) acc[b] += sil[b * D + k0 + q] * wv[q];
        }
        LAS f32x2v* red2 = (LAS f32x2v*)red;
#pragma unroll
        for (int b = 0; b < 8; ++b) red2[(F.wave * 8 + b) * 64 + F.lane] = acc[b];
        __syncthreads();
        { const int b = F.wave; f32x2v sm = {0.f, 0.f};
#pragma unroll
          for (int w2 = 0; w2 < 8; ++w2) sm += red2[(w2 * 8 + b) * 64 + F.lane];
          const f32x2v bia = *(const f32x2v*)(F.in[11] + l * 6144 + n0);
          *(f32x2v*)((float*)(F.ws + WS_MOD) + ((size_t)l * 8 + b) * 6144 + n0) = sm + bia; }
        __syncthreads();
    }
}

__device__ __forceinline__ void ln_stats(const f32x4 (&v)[4], float& mean, float& rstd) {
    float s = 0.f;
#pragma unroll
    for (int j = 0; j < 4; ++j) s += (v[j].x + v[j].y) + (v[j].z + v[j].w);
    mean = wsum(s) * (1.f / D);
    float s2 = 0.f;
#pragma unroll
    for (int j = 0; j < 4; ++j) { const f32x4 d = v[j] - mean; s2 += (d.x * d.x + d.y * d.y) + (d.z * d.z + d.w * d.w); }
    rstd = 1.f / sqrtf(wsum(s2) * (1.f / D) + LN_EPS);
}
__device__ __forceinline__ void load_row(const float* p, int lane, f32x4 (&v)[4]) {
#pragma unroll
    for (int j = 0; j < 4; ++j) v[j] = *(const f32x4*)(p + 256 * j + 4 * lane);
}
__device__ __forceinline__ void load_row_bf16(const bf16* p, int lane, f32x4 (&v)[4]) {
#pragma unroll
    for (int j = 0; j < 4; ++j) { const u32x2 q = *(const u32x2*)(p + 256 * j + 4 * lane);
        v[j] = (f32x4){__uint_as_float(q.x << 16), __uint_as_float(q.x & 0xffff0000u), __uint_as_float(q.y << 16), __uint_as_float(q.y & 0xffff0000u)}; }
}
__device__ __forceinline__ void store_row(float* p, int lane, const f32x4 (&v)[4]) {
#pragma unroll
    for (int j = 0; j < 4; ++j) *(f32x4*)(p + 256 * j + 4 * lane) = v[j];
}
__device__ __forceinline__ void store_row_bf16(bf16* p, int lane, const f32x4 (&v)[4]) {
#pragma unroll
    for (int j = 0; j < 4; ++j) { u32x2 o; o.x = cvt_pk_bf16(v[j].x, v[j].y); o.y = cvt_pk_bf16(v[j].z, v[j].w); *(u32x2*)(p + 256 * j + 4 * lane) = o; }
}
__device__ __forceinline__ void ada_ln(f32x4 (&v)[4], const float* sh, const float* sc, int lane) {
    float mean, rstd; ln_stats(v, mean, rstd);
    f32x4 a[4], b[4]; load_row(sc, lane, a); load_row(sh, lane, b);
#pragma unroll
    for (int j = 0; j < 4; ++j) v[j] = (v[j] - mean) * rstd * (1.f + a[j]) + b[j];
}
__device__ __forceinline__ void deepnorm(f32x4 (&x)[4], const f32x4 (&y)[4], const float* g, const float* lg, const float* lb, int lane) {
    f32x4 a[4]; load_row(g, lane, a);
#pragma unroll
    for (int j = 0; j < 4; ++j) x[j] = ALPHA * x[j] + (1.f + a[j]) * y[j];
    float mean, rstd; ln_stats(x, mean, rstd);
    f32x4 b[4]; load_row(lg, lane, a); load_row(lb, lane, b);
#pragma unroll
    for (int j = 0; j < 4; ++j) x[j] = (x[j] - mean) * rstd * a[j] + b[j];
}

struct RowIn2 { f32x4 x[4]; u32x2 xb[4]; u32x2 y[4][4]; };
template <int MODE> __device__ __forceinline__ void row_load(const Frame& F, int row, int lane, RowIn2& r) {
    if (MODE == 0) { load_row(F.in[0] + (size_t)row * D, lane, r.x); return; }
#pragma unroll
    for (int j = 0; j < 4; ++j) r.xb[j] = *(const u32x2*)((const bf16*)(F.ws + WS_XB) + (size_t)row * D + 256 * j + 4 * lane);
    const bf16* yk = (const bf16*)(F.ws + WS_YK) + (size_t)row * 4 * D + 4 * lane;
#pragma unroll
    for (int k = 0; k < 4; ++k)
#pragma unroll
        for (int j = 0; j < 4; ++j) r.y[k][j] = *(const u32x2*)(yk + k * D + 256 * j);
}
__device__ __forceinline__ f32x4 bf4(u32x2 q) { return (f32x4){__uint_as_float(q.x << 16), __uint_as_float(q.x & 0xffff0000u), __uint_as_float(q.y << 16), __uint_as_float(q.y & 0xffff0000u)}; }
template <int MODE> __device__ __forceinline__ void phase_row(const Frame& F, int l) {
    const int gw = F.bid * NWAVES + F.wave, NGW = F.G * NWAVES, lane = F.lane;
    const float* MOD = (const float*)(F.ws + WS_MOD);
    bf16* H = (bf16*)(F.ws + WS_H);
    RowIn2 cur, nxt;
    if (gw < T) row_load<MODE>(F, gw, lane, cur);
    for (int row = gw; row < T; row += NGW) {
        const int b = row >> 11;
        const float* modp = MOD + ((size_t)l * 8 + b) * 6144;
        if (row + NGW < T) row_load<MODE>(F, row + NGW, lane, nxt);
        f32x4 x[4];
#pragma unroll
        for (int j = 0; j < 4; ++j) x[j] = MODE == 0 ? cur.x[j] : bf4(cur.xb[j]);
        if (MODE == 0) {
            ada_ln(x, modp, modp + 1024, lane);
            store_row_bf16(H + (size_t)row * D, lane, x);
        } else {
            f32x4 y[4];
#pragma unroll
            for (int j = 0; j < 4; ++j) y[j] = (bf4(cur.y[0][j]) + bf4(cur.y[1][j])) + (bf4(cur.y[2][j]) + bf4(cur.y[3][j]));
            deepnorm(x, y, modp + 5 * 1024, F.in[12] + (l * 2 + 1) * D, F.in[13] + (l * 2 + 1) * D, lane);
            if (l + 1 == DEPTH) store_row(((float*)F.out) + (size_t)row * D, lane, x);
            else {
                store_row_bf16((bf16*)(F.ws + WS_XB) + (size_t)row * D, lane, x);
                const float* modn = MOD + ((size_t)(l + 1) * 8 + b) * 6144;
                ada_ln(x, modn, modn + 1024, lane);
                store_row_bf16(H + (size_t)row * D, lane, x);
            }
        }
        if (row + NGW < T) {
#pragma unroll
            for (int j = 0; j < 4; ++j) { if (MODE == 0) cur.x[j] = nxt.x[j]; else cur.xb[j] = nxt.xb[j];
#pragma unroll
                for (int k = 0; k < 4; ++k) cur.y[k][j] = nxt.y[k][j]; }
        }
    }
}

__device__ __forceinline__ void ada_ln_r(f32x4 (&v)[4], const f32x4 (&sc1)[4], const f32x4 (&sh)[4]) {
    float mean, rstd; ln_stats(v, mean, rstd);
#pragma unroll
    for (int j = 0; j < 4; ++j) v[j] = (v[j] - mean) * rstd * sc1[j] + sh[j];
}
__device__ __forceinline__ void deepnorm_r(f32x4 (&x)[4], const f32x4 (&y)[4], const f32x4 (&g1)[4], const f32x4 (&lg)[4], const f32x4 (&lb)[4]) {
#pragma unroll
    for (int j = 0; j < 4; ++j) x[j] = ALPHA * x[j] + g1[j] * y[j];
    float mean, rstd; ln_stats(x, mean, rstd);
#pragma unroll
    for (int j = 0; j < 4; ++j) x[j] = (x[j] - mean) * rstd * lg[j] + lb[j];
}
__device__ __forceinline__ void phase_row0(const Frame& F) {
    const int lane = F.lane;
    const float* MOD = (const float*)(F.ws + WS_MOD);
    bf16* H = (bf16*)(F.ws + WS_H);
    for (int chunk = F.bid; chunk < T / 64; chunk += F.G) {
        const int row0 = chunk * 64 + F.wave * 8, b = row0 >> 11;
        const float* modp = MOD + (size_t)b * 6144;
        f32x4 sc1[4], sh[4];
        load_row(modp, lane, sh); load_row(modp + 1024, lane, sc1);
#pragma unroll
        for (int j = 0; j < 4; ++j) sc1[j] = sc1[j] + 1.f;
        f32x4 cx[4], nx[4];
        load_row(F.in[0] + (size_t)row0 * D, lane, cx);
        for (int i = 0; i < 8; ++i) {
            const int row = row0 + i;
            if (i + 1 < 8) load_row(F.in[0] + (size_t)(row + 1) * D, lane, nx);
            f32x4 x[4];
#pragma unroll
            for (int j = 0; j < 4; ++j) x[j] = cx[j];
            ada_ln_r(x, sc1, sh);
            store_row_bf16(H + (size_t)row * D, lane, x);
#pragma unroll
            for (int j = 0; j < 4; ++j) cx[j] = nx[j];
        }
    }
}
__device__ __forceinline__ void phase_row2(const Frame& F, int l) {
    const int lane = F.lane;
    const float* MOD = (const float*)(F.ws + WS_MOD);
    bf16* H = (bf16*)(F.ws + WS_H); bf16* XB = (bf16*)(F.ws + WS_XB);
    for (int chunk = F.bid; chunk < T / 64; chunk += F.G) {
        const int row0 = chunk * 64 + F.wave * 8, b = row0 >> 11;
        const float* modp = MOD + ((size_t)l * 8 + b) * 6144;
        f32x4 g1[4], lg[4], lb[4], sc1[4], sh[4];
        load_row(modp + 5 * 1024, lane, g1); load_row(F.in[12] + (l * 2 + 1) * D, lane, lg); load_row(F.in[13] + (l * 2 + 1) * D, lane, lb);
#pragma unroll
        for (int j = 0; j < 4; ++j) g1[j] = g1[j] + 1.f;
        if (l + 1 < DEPTH) { const float* modn = MOD + ((size_t)(l + 1) * 8 + b) * 6144; load_row(modn, lane, sh); load_row(modn + 1024, lane, sc1);
#pragma unroll
            for (int j = 0; j < 4; ++j) sc1[j] = sc1[j] + 1.f; }
        else {
#pragma unroll
            for (int j = 0; j < 4; ++j) { sh[j] = (f32x4){0.f, 0.f, 0.f, 0.f}; sc1[j] = sh[j]; } }
        u32x2 cxb[4], nxb[4], cy[4][4], ny[4][4];
        { const bf16* yk = (const bf16*)(F.ws + WS_YK) + (size_t)row0 * 4 * D + 4 * lane;
#pragma unroll
          for (int j = 0; j < 4; ++j) { cxb[j] = *(const u32x2*)(XB + (size_t)row0 * D + 256 * j + 4 * lane);
#pragma unroll
              for (int k = 0; k < 4; ++k) cy[k][j] = *(const u32x2*)(yk + k * D + 256 * j); } }
        for (int i = 0; i < 8; ++i) {
            const int row = row0 + i;
            if (i + 1 < 8) { const bf16* yk = (const bf16*)(F.ws + WS_YK) + (size_t)(row + 1) * 4 * D + 4 * lane;
#pragma unroll
                for (int j = 0; j < 4; ++j) { nxb[j] = *(const u32x2*)(XB + (size_t)(row + 1) * D + 256 * j + 4 * lane);
#pragma unroll
                    for (int k = 0; k < 4; ++k) ny[k][j] = *(const u32x2*)(yk + k * D + 256 * j); } }
            f32x4 x[4], y[4];
#pragma unroll
            for (int j = 0; j < 4; ++j) { x[j] = bf4(cxb[j]); y[j] = (bf4(cy[0][j]) + bf4(cy[1][j])) + (bf4(cy[2][j]) + bf4(cy[3][j])); }
            deepnorm_r(x, y, g1, lg, lb);
            if (l + 1 == DEPTH) store_row(((float*)F.out) + (size_t)row * D, lane, x);
            else {
                store_row_bf16(XB + (size_t)row * D, lane, x);
                ada_ln_r(x, sc1, sh);
                store_row_bf16(H + (size_t)row * D, lane, x);
            }
#pragma unroll
            for (int j = 0; j < 4; ++j) { cxb[j] = nxb[j];
#pragma unroll
                for (int k = 0; k < 4; ++k) cy[k][j] = ny[k][j]; }
        }
    }
}
__device__ __forceinline__ void phase_row1(const Frame& F, int l) {
    const int lane = F.lane, w = F.wave;
    const float* MOD = (const float*)(F.ws + WS_MOD);
    bf16* H = (bf16*)(F.ws + WS_H);
    float* H32 = (float*)(F.ws + WS_PROJ);
    LAS float* lg = (LAS float*)F.lds;
    volatile LAS int* lc = (volatile LAS int*)(F.lds + 16384);
    for (int chunk = F.bid; chunk < T / 64; chunk += F.G) {
        __syncthreads();
        if (F.tid < 64) lc[F.tid] = 0;
        const bf16* XB = (const bf16*)(F.ws + WS_XB);
        f32x4 g1[4], vlg[4], vlb[4], sc1[4], sh[4];
        { const float* modp = MOD + ((size_t)l * 8 + ((chunk * 64) >> 11)) * 6144;
          load_row(modp + 2048, lane, g1); load_row(F.in[12] + (l * 2 + 0) * D, lane, vlg); load_row(F.in[13] + (l * 2 + 0) * D, lane, vlb); load_row(modp + 3 * 1024, lane, sh); load_row(modp + 4 * 1024, lane, sc1);
#pragma unroll
          for (int j = 0; j < 4; ++j) { g1[j] = g1[j] + 1.f; sc1[j] = sc1[j] + 1.f; } }
        f32x4 cx[4], nx[4]; u32x2 cy[4], ny[4];
        { const int row = chunk * 64 + w * 8; if (l == 0) load_row(F.in[0] + (size_t)row * D, lane, cx); else load_row_bf16(XB + (size_t)row * D, lane, cx);
#pragma unroll
          for (int j = 0; j < 4; ++j) cy[j] = *(const u32x2*)((const bf16*)(F.ws + WS_MIX) + (size_t)row * D + 256 * j + 4 * lane); }
        for (int i = 0; i < 8; ++i) {
            const int row = chunk * 64 + w * 8 + i, b = row >> 11;
            const float* modp = MOD + ((size_t)l * 8 + b) * 6144;
            if (i + 1 < 8) { if (l == 0) load_row(F.in[0] + (size_t)(row + 1) * D, lane, nx); else load_row_bf16(XB + (size_t)(row + 1) * D, lane, nx);
#pragma unroll
                for (int j = 0; j < 4; ++j) ny[j] = *(const u32x2*)((const bf16*)(F.ws + WS_MIX) + (size_t)(row + 1) * D + 256 * j + 4 * lane); }
            f32x4 x[4], y[4];
#pragma unroll
            for (int j = 0; j < 4; ++j) { x[j] = cx[j]; y[j] = bf4(cy[j]); }
            deepnorm_r(x, y, g1, vlg, vlb);
            store_row_bf16((bf16*)(F.ws + WS_XB) + (size_t)row * D, lane, x);
            ada_ln_r(x, sc1, sh);
            store_row(H32 + (size_t)row * D, lane, x);
            {
                float am = 0.f;
#pragma unroll
                for (int j = 0; j < 4; ++j) am = fmaxf(am, fmaxf(fmaxf(fabsf(x[j].x), fabsf(x[j].y)), fmaxf(fabsf(x[j].z), fabsf(x[j].w))));
                am = fmaxf(wmaxf(am), 1e-20f);
                const float qs = 224.f / am;
                unsigned char* hq = (unsigned char*)(F.ws + WS_HQ) + (size_t)row * D;
#pragma unroll
                for (int j = 0; j < 4; ++j) *(unsigned*)(hq + 256 * j + 4 * lane) = pk4_fp8(x[j] * qs);
                if (lane == 0) ((float*)(F.ws + WS_HS))[row] = am * (1.f / 224.f);
            }
#pragma unroll
            for (int j = 0; j < 4; ++j) { cx[j] = nx[j]; cy[j] = ny[j]; }
        }
        asm volatile("s_waitcnt vmcnt(0)" ::: "memory");
        __syncthreads();
        {
            const int fr = lane & 15, fq = lane >> 4, tile = w >> 1, nt = w & 1;
            const float* wp = (const float*)(F.ws + WS_RWT) + ((size_t)l * NE + 16 * nt + fr) * D + 256 * fq;
            const float* hp = H32 + (size_t)(chunk * 64 + 16 * tile + fr) * D + 256 * fq;
            f32x4 c = {0.f, 0.f, 0.f, 0.f};
#pragma unroll 16
            for (int s4 = 0; s4 < 256; s4 += 4) { const f32x4 a = *(const f32x4*)(wp + s4), bq = *(const f32x4*)(hp + s4);
                c = __builtin_amdgcn_mfma_f32_16x16x4f32(a.x, bq.x, c, 0, 0, 0); c = __builtin_amdgcn_mfma_f32_16x16x4f32(a.y, bq.y, c, 0, 0, 0);
                c = __builtin_amdgcn_mfma_f32_16x16x4f32(a.z, bq.z, c, 0, 0, 0); c = __builtin_amdgcn_mfma_f32_16x16x4f32(a.w, bq.w, c, 0, 0, 0); }
#pragma unroll
            for (int j = 0; j < 4; ++j) { const int e = 16 * nt + 4 * fq + j; lg[(16 * tile + fr) * 33 + e] = c[j] + F.in[15][l * NE + e]; }
        }
        __syncthreads();
        if (w == 0) {
            const int row = chunk * 64 + lane;
            float v[32];
#pragma unroll
            for (int e = 0; e < 32; ++e) v[e] = lg[lane * 33 + e];
            float tv[4]; int ti[4];
#pragma unroll
            for (int r = 0; r < 4; ++r) { float bv = v[0]; int bi = 0;
#pragma unroll
                for (int e = 1; e < 32; ++e) { const bool tk = v[e] > bv; bv = tk ? v[e] : bv; bi = tk ? e : bi; }
                tv[r] = bv; ti[r] = bi;
#pragma unroll
                for (int e = 0; e < 32; ++e) v[e] = (e == bi) ? -INFINITY : v[e]; }
            float ev[4], es = 0.f;
#pragma unroll
            for (int r = 0; r < 4; ++r) { ev[r] = expf(tv[r] - tv[0]); es += ev[r]; }
            const float rowscale = ((const float*)(F.ws + WS_HS))[row];
            int lp[4];
#pragma unroll
            for (int r = 0; r < 4; ++r) lp[r] = __hip_atomic_fetch_add((LAS int*)(F.lds + 16384) + ti[r], 1, __ATOMIC_RELAXED, __HIP_MEMORY_SCOPE_WORKGROUP);
            LDS_WAIT();
            int base = 0;
            if (lane < 32) { const int c = lc[lane]; unsigned* cnt = (unsigned*)(F.ws + WS_CTL) + CW_CNT + l * NE; base = c > 0 ? (int)atomicAdd(cnt + lane, (unsigned)c) : 0; }
#pragma unroll
            for (int r = 0; r < 4; ++r) { const int bs = __shfl(base, ti[r]);
                ((int*)(F.ws + WS_LIST))[(size_t)ti[r] * T + bs + lp[r]] = row * 4 + r;
                ((float*)(F.ws + WS_LHS))[(size_t)ti[r] * T + bs + lp[r]] = rowscale;
                ((float*)(F.ws + WS_LGW))[(size_t)ti[r] * T + bs + lp[r]] = ev[r] / es;
                ((float*)(F.ws + WS_GATEW))[row * 4 + r] = ev[r] / es; }
        }
    }
}

struct GemmCtx { int wr, wc, fr, fq; };
template <class RowFn, class Epi>
__device__ __forceinline__ void gemm_unit(const Frame& F, const bf16* A, const RowFn& arow, const bf16* Bt, const Epi& E, const int nk = 32, const int ldb = D) {
    const int tid = F.tid, lane = F.lane, wid = F.wave;
    GemmCtx cx; cx.wr = wid >> 1; cx.wc = wid & 1; cx.fr = lane & 15; cx.fq = lane >> 4;
    const int sr = tid >> 2, sc = (tid & 3) * 8;
    const bf16* srcA0 = A + (size_t)arow(sr) * D + sc;
    const bf16* srcA1 = A + (size_t)arow(sr + 128) * D + sc;
    const bf16* srcB = Bt + (size_t)sr * ldb + sc;
    LAS unsigned char* lds = F.lds;
    f32x4 acc[4][4];
#pragma unroll
    for (int m = 0; m < 4; ++m)
#pragma unroll
        for (int n = 0; n < 4; ++n) acc[m][n] = (f32x4){0.f, 0.f, 0.f, 0.f};
#define STAGE(t, buf) do { \
        __builtin_amdgcn_global_load_lds((const unsigned*)(srcA0 + (t) * 32), (LAS unsigned*)(lds + (buf) * 24576 + tid * 16), 16, 0, 0); \
        __builtin_amdgcn_global_load_lds((const unsigned*)(srcA1 + (t) * 32), (LAS unsigned*)(lds + (buf) * 24576 + 8192 + tid * 16), 16, 0, 0); \
        __builtin_amdgcn_global_load_lds((const unsigned*)(srcB + (t) * 32), (LAS unsigned*)(lds + (buf) * 24576 + 16384 + tid * 16), 16, 0, 0); } while (0)
    const int aoff = (cx.wr * 64 + cx.fr) * 64 + cx.fq * 16, boff = (cx.wc * 64 + cx.fr) * 64 + cx.fq * 16;
    __syncthreads();
    STAGE(0, 0); if (nk > 1) STAGE(1, 1); if (nk > 2) STAGE(2, 2);
    for (int t = 0; t < nk; ++t) {
        if (t + 2 < nk) asm volatile("s_waitcnt vmcnt(6)" ::: "memory"); else if (t + 1 < nk) asm volatile("s_waitcnt vmcnt(3)" ::: "memory"); else asm volatile("s_waitcnt vmcnt(0)" ::: "memory");
        __syncthreads();
        if (t + 3 < nk) STAGE(t + 3, (t + 3) & 3);
        const LAS unsigned char* ba = lds + (t & 3) * 24576 + aoff;
        const LAS unsigned char* bb = lds + (t & 3) * 24576 + 16384 + boff;
        bf16x8 a[4], b[4];
#pragma unroll
        for (int m = 0; m < 4; ++m) a[m] = *(const LAS bf16x8*)(ba + m * 1024);
#pragma unroll
        for (int n = 0; n < 4; ++n) b[n] = *(const LAS bf16x8*)(bb + n * 1024);
#pragma unroll
        for (int m = 0; m < 4; ++m)
#pragma unroll
            for (int n = 0; n < 4; ++n) acc[m][n] = __builtin_amdgcn_mfma_f32_16x16x32_bf16(b[n], a[m], acc[m][n], 0, 0, 0);
    }
#undef STAGE
    E(acc, cx);
}


namespace pg8 {
constexpr int BM = 256, BK = 64, HALF = 128, HTB = HALF * BK * 2, NXCD = 8, WGM = 8, KK = 1024, NT = KK / BK;
constexpr int NA_OFF = 131072 + 1024;
constexpr int SB_SIZE = 3072;
__device__ __forceinline__ int lds_byte(int r, int c) { const int st = (r >> 4) * 2 + (c >> 5), rr = r & 15, cc = c & 31, ob = rr * 64 + cc * 2; return st * 1024 + (ob ^ (((ob >> 9) & 1) << 5)); }
__device__ __forceinline__ void stage_rc(int b, int& R, int& C) { const int st = b / 1024, sb = b % 1024, swz = sb ^ (((sb >> 9) & 1) << 5); R = (st >> 1) * 16 + swz / 64; C = (st & 1) * 32 + (swz % 64) / 2; }
struct Unit { int pm, pn, e, nvalid, lrow0; };
__device__ __forceinline__ int xcd_remap(int L, int nwg) { const int q = nwg / NXCD, r = nwg % NXCD, xcd = L % NXCD, off = L / NXCD; return (xcd < r ? xcd * (q + 1) : r * (q + 1) + (xcd - r) * q) + off; }
struct StaticOrder {
    int nM, nN, nwg, G, c;
    __device__ __forceinline__ void init(int M, int N, int G_, int c_) { nM = M / BM; nN = N / BM; nwg = nM * nN; G = G_; c = c_; }
    __device__ __forceinline__ bool next(int i, Unit& u) const {
        const int L = i * G + c; if (L >= nwg) return false;
        const int wgid = xcd_remap(L, nwg);
        const int nig = WGM * nN, gid = wgid / nig, fm = gid * WGM, gsz = (nM - fm) < WGM ? (nM - fm) : WGM;
        u.pm = fm + ((wgid % nig) % gsz); u.pn = (wgid % nig) / gsz; u.e = 0; u.nvalid = 256; u.lrow0 = 0; return true;
    }
};
struct MoeOrder {
    volatile LAS int* M; int NCT, nwg, G, c;
    __device__ __forceinline__ bool next(int i, Unit& u) const {
        const int L = i * G + c; if (L >= nwg) return false;
        const int wgid = xcd_remap(L, nwg);
        const int rtg = wgid / NCT; u.pn = wgid % NCT;
        int e = 0;
#pragma unroll 1
        for (int step = 16; step >= 1; step >>= 1) e = (rtg >= M[48 + e + step]) ? e + step : e;
        const int rt = rtg - M[48 + e];
        u.pm = rtg; u.e = e; u.lrow0 = rt * 256; u.nvalid = min(256, M[16 + e] - rt * 256); return true;
    }
};
struct ADense { __device__ __forceinline__ int operator()(const Unit& u, int rl) const { return u.pm * 256 + rl; } };
struct AGather { const int* list; __device__ __forceinline__ int operator()(const Unit& u, int rl) const { return list[(size_t)u.e * T + u.lrow0 + min(rl, u.nvalid - 1)] >> 2; } };
struct BDense { const bf16* Bt; __device__ __forceinline__ const char* operator()(const Unit& u) const { return (const char*)(Bt + (size_t)u.pn * 256 * KK); } };
struct BExpert8 { const unsigned char* Bt; size_t estride; __device__ __forceinline__ const char* operator()(const Unit& u) const { return (const char*)(Bt + (size_t)u.e * estride + (size_t)u.pn * 256 * KK); } };
typedef int i32x8 __attribute__((ext_vector_type(8)));
typedef int i32x4_ __attribute__((ext_vector_type(4)));

template <bool FP8, class Epi, class Sched, class ARow, class BBase>
__device__ __forceinline__ void gemm_phase(LAS unsigned char* lds, const void* Abase, const ARow& AR, const BBase& BB, const Sched& S, const Epi& E, int tid) {
    const int wid = __builtin_amdgcn_readfirstlane(tid >> 6), lane = tid & 63, wr = wid >> 2, wc = wid & 3, fr = lane & 15, fq = lane >> 4;
    constexpr int RB = FP8 ? KK : KK * 2, nt = RB / 128;
    unsigned voffB[2];
#pragma unroll
    for (int i = 0; i < 2; ++i) { int R, C; stage_rc(tid * 16 + i * 8192, R, C); voffB[i] = (unsigned)(R * RB + C * 2); }
    constexpr size_t kstep = (size_t)(BK * 2), hstep = (size_t)HALF * RB;
    const unsigned ldsw = (unsigned)wid * 1024u;
    const int aoff = lds_byte(wr * 64 + fr, fq * 8), boff = lds_byte(wc * 32 + fr, fq * 8);
    const char* Ab = (const char*)Abase;
#define PG8_SA(b, h) (((b) * 2 + (h)) * HTB)
#define PG8_SB(b, h) ((4 + (b) * 2 + (h)) * HTB)
#define PG8_STAGEB(bufoff, gbase) do { _Pragma("unroll") for (int _i = 0; _i < 2; ++_i) \
        __builtin_amdgcn_global_load_lds((const unsigned*)((gbase) + voffB[_i]), (LAS unsigned*)(lds + (bufoff) + ldsw + _i * 8192), 16, 0, 0); } while (0)
#define PG8_STAGEA(bufoff, offs, h, kb) do { _Pragma("unroll") for (int _i = 0; _i < 2; ++_i) \
        __builtin_amdgcn_global_load_lds((const unsigned*)(Ab + (size_t)((offs)[h][_i] + (unsigned)(kb))), (LAS unsigned*)(lds + (bufoff) + ldsw + _i * 8192), 16, 0, 0); } while (0)
#define PG8_LDA(dst, b, h) do { _Pragma("unroll") for (int m = 0; m < 4; ++m) _Pragma("unroll") for (int k = 0; k < 2; ++k) dst[m][k] = *(const LAS bf16x8*)(lds + PG8_SA(b, h) + aoff + m * 2048 + k * 1024); } while (0)
#define PG8_LDB(dst, b, h) do { _Pragma("unroll") for (int n = 0; n < 2; ++n) _Pragma("unroll") for (int k = 0; k < 2; ++k) dst[n][k] = *(const LAS bf16x8*)(lds + PG8_SB(b, h) + boff + n * 2048 + k * 1024); } while (0)
#define PG8_CAT(x) __builtin_shufflevector(__builtin_bit_cast(i32x4_, (x)[0]), __builtin_bit_cast(i32x4_, (x)[1]), 0, 1, 2, 3, 4, 5, 6, 7)
#define PG8_MMA(ai, bj, At, Bt) do { __builtin_amdgcn_s_setprio(1); _Pragma("unroll") for (int m = 0; m < 4; ++m) _Pragma("unroll") for (int n = 0; n < 2; ++n) { \
        if constexpr (FP8) acc[ai][bj][m][n] = __builtin_amdgcn_mfma_scale_f32_16x16x128_f8f6f4(PG8_CAT(Bt[n]), PG8_CAT(At[m]), acc[ai][bj][m][n], 0, 0, 0, 0x7F7F7F7F, 0, 0x7F7F7F7F); \
        else { _Pragma("unroll") for (int k = 0; k < 2; ++k) acc[ai][bj][m][n] = __builtin_amdgcn_mfma_f32_16x16x32_bf16(Bt[n][k], At[m][k], acc[ai][bj][m][n], 0, 0, 0); } } \
        __builtin_amdgcn_s_setprio(0); } while (0)
#define PG8_WAIT_V(n) asm volatile("s_waitcnt vmcnt(" #n ")" ::: "memory")
#define PG8_WAIT_L(n) asm volatile("s_waitcnt lgkmcnt(" #n ")" ::: "memory")
#define PG8_BAR __builtin_amdgcn_s_barrier()
#define PG8_SCHED __builtin_amdgcn_sched_barrier(0)
#define PG8_AOFFS(dst, u) do { int _t = tid; asm volatile("" : "+v"(_t)); _Pragma("unroll") for (int _i = 0; _i < 2; ++_i) { int _R, _C; stage_rc(_t * 16 + _i * 8192, _R, _C); \
        _Pragma("unroll") for (int _h = 0; _h < 2; ++_h) dst[_h][_i] = (unsigned)AR((u), _h * HALF + _R) * (unsigned)RB + (unsigned)_C * 2u; } } while (0)
    Unit cur, nxt; int ui = 0;
    if (!S.next(0, cur)) return;
    f32x4 acc[2][2][4][2];
#pragma unroll
    for (int a = 0; a < 2; ++a)
#pragma unroll
        for (int b = 0; b < 2; ++b)
#pragma unroll
            for (int m = 0; m < 4; ++m)
#pragma unroll
                for (int n = 0; n < 2; ++n) acc[a][b][m][n] = (f32x4){0.f, 0.f, 0.f, 0.f};
    bf16x8 At[4][2], B0[2][2], B1[2][2];
    unsigned cA[2][2];
    PG8_AOFFS(cA, cur);
    const char* cB = BB(cur);
    PG8_STAGEB(PG8_SB(0, 0), cB); PG8_STAGEB(PG8_SB(0, 1), cB + hstep); PG8_STAGEA(PG8_SA(0, 0), cA, 0, 0); PG8_STAGEA(PG8_SA(0, 1), cA, 1, 0);
    PG8_STAGEB(PG8_SB(1, 0), cB + kstep); PG8_STAGEA(PG8_SA(1, 0), cA, 0, kstep); PG8_STAGEB(PG8_SB(1, 1), cB + hstep + kstep);
    if (wr == 1) PG8_BAR;
    PG8_WAIT_V(8); PG8_BAR;
    PG8_WAIT_V(6); PG8_BAR;
    for (;;) {
        const bool has_next = S.next(ui + 1, nxt);
        const char* nB = cB;
        {
            unsigned nA[2][2];
            if (has_next) { PG8_AOFFS(nA, nxt); nB = BB(nxt); }
            else {
#pragma unroll
                for (int _h = 0; _h < 2; ++_h)
#pragma unroll
                    for (int _i = 0; _i < 2; ++_i) nA[_h][_i] = cA[_h][_i];
            }
            *(LAS u32x4*)(lds + NA_OFF + tid * 16) = (u32x4){nA[0][0], nA[0][1], nA[1][0], nA[1][1]};
        }
        if constexpr (Epi::PREFETCH) E.prefetch(lds + (ui & 1) * SB_SIZE, cur, tid);
        for (int t = 0; t < nt; t += 2) {
            const bool last = (t == nt - 2);
            const unsigned k1 = (unsigned)((t + 1) * kstep), kb2 = last ? 0u : (unsigned)((t + 2) * kstep);
            const char* b2 = last ? nB : cB + (size_t)(t + 2) * kstep; const char* b3 = b2 + kstep;
            PG8_LDB(B0, 0, 0); PG8_LDB(B1, 0, 1); PG8_SCHED; PG8_LDA(At, 0, 0); PG8_STAGEA(PG8_SA(1, 1), cA, 1, k1);
            if (last) { const u32x4 q = *(const LAS u32x4*)(lds + NA_OFF + tid * 16); cA[0][0] = q.x; cA[0][1] = q.y; cA[1][0] = q.z; cA[1][1] = q.w; }
            PG8_WAIT_V(8); PG8_WAIT_L(0); PG8_BAR; PG8_MMA(0, 0, At, B0); PG8_MMA(0, 1, At, B1); PG8_BAR; PG8_SCHED;
            PG8_LDA(At, 0, 1); PG8_STAGEB(PG8_SB(0, 0), b2); PG8_STAGEB(PG8_SB(0, 1), b2 + hstep); PG8_STAGEA(PG8_SA(0, 0), cA, 0, kb2);
            PG8_WAIT_V(8); PG8_WAIT_L(0); PG8_BAR; PG8_MMA(1, 0, At, B0); PG8_MMA(1, 1, At, B1); PG8_BAR; PG8_SCHED;
            PG8_LDB(B0, 1, 0); PG8_LDB(B1, 1, 1); PG8_SCHED; PG8_LDA(At, 1, 0); PG8_STAGEA(PG8_SA(0, 1), cA, 1, kb2);
            PG8_WAIT_V(8); PG8_WAIT_L(0); PG8_BAR; PG8_MMA(0, 0, At, B0); PG8_MMA(0, 1, At, B1); PG8_BAR; PG8_SCHED;
            PG8_LDA(At, 1, 1); PG8_STAGEB(PG8_SB(1, 0), b3); PG8_STAGEB(PG8_SB(1, 1), b3 + hstep); PG8_STAGEA(PG8_SA(1, 0), cA, 0, kb2 + (unsigned)kstep);
            PG8_WAIT_V(8); PG8_WAIT_L(0); PG8_BAR; PG8_MMA(1, 0, At, B0); PG8_MMA(1, 1, At, B1); PG8_BAR; PG8_SCHED;
        }
        if (wr == 0) PG8_BAR;
        { int efr = fr, efq = fq; asm volatile("" : "+v"(efr), "+v"(efq));
          if constexpr (Epi::PREFETCH) E(acc, cur, wr, wc, efr, efq, lds + (ui & 1) * SB_SIZE); else E(acc, cur, wr, wc, efr, efq); }
        if (!has_next) break;
#pragma unroll
        for (int a = 0; a < 2; ++a)
#pragma unroll
            for (int b = 0; b < 2; ++b)
#pragma unroll
                for (int m = 0; m < 4; ++m)
#pragma unroll
                    for (int n = 0; n < 2; ++n) acc[a][b][m][n] = (f32x4){0.f, 0.f, 0.f, 0.f};
        cur = nxt; cB = nB; ++ui;
        if (wr == 1) PG8_BAR;
    }
    PG8_WAIT_V(0);
    PG8_BAR;
#undef PG8_SA
#undef PG8_SB
#undef PG8_STAGEA
#undef PG8_STAGEB
#undef PG8_LDA
#undef PG8_LDB
#undef PG8_MMA
#undef PG8_CAT
#undef PG8_WAIT_V
#undef PG8_WAIT_L
#undef PG8_BAR
#undef PG8_SCHED
#undef PG8_AOFFS
}
}

struct RowIdent { int row0; __device__ __forceinline__ int operator()(int r) const { return row0 + r; } };
struct RowList { const int* list; int nvalid; __device__ __forceinline__ int operator()(int r) const { return r < nvalid ? (list[r] >> 2) : 0; } };

struct EpiF32 {
    float* C; int ld, row0, col0;
    __device__ __forceinline__ void operator()(const f32x4 (&acc)[4][4], const GemmCtx& cx) const {
#pragma unroll
        for (int m = 0; m < 4; ++m) { float* rp = C + (size_t)(row0 + cx.wr * 64 + m * 16 + cx.fr) * ld + col0 + cx.wc * 64 + cx.fq * 4;
#pragma unroll
            for (int n = 0; n < 4; ++n) *(f32x4*)(rp + n * 16) = acc[m][n]; }
    }
};

__device__ __forceinline__ void st4bf(bf16* dst, f32x4 v) { u32x2 o; o.x = cvt_pk_bf16(v.x, v.y); o.y = cvt_pk_bf16(v.z, v.w); *(u32x2*)dst = o; }
__device__ __forceinline__ void st8bf(bf16* dst, f32x4 a, f32x4 b) { u32x4 o; o.x = cvt_pk_bf16(a.x, a.y); o.y = cvt_pk_bf16(a.z, a.w); o.z = cvt_pk_bf16(b.x, b.y); o.w = cvt_pk_bf16(b.z, b.w); *(u32x4*)dst = o; }
__device__ __forceinline__ float bf2f(unsigned short x) { return __uint_as_float(((unsigned)x) << 16); }
struct EpiIn {
    unsigned char* ws; int row0, col0;
    __device__ __forceinline__ void operator()(const f32x4 (&acc)[4][4], const GemmCtx& cx) const {
        if (KEEP_PROJ) { EpiF32 e{(float*)(ws + WS_PROJ), PLD, row0, col0}; e(acc, cx); }
        const int G = (col0 + cx.wc * 64) >> 6;
        if (G >= 49) return;
        const int dq = cx.fq * 4;
        const bool rope = (G < 8) || (G >= 28 && G < 36) || G == 40 || G == 41 || G == 44 || G == 45;
        do_row(acc[0][0], acc[0][1], acc[0][2], acc[0][3], row0 + cx.wr * 64 + 0 * 16 + cx.fr, G, dq, rope);
        do_row(acc[1][0], acc[1][1], acc[1][2], acc[1][3], row0 + cx.wr * 64 + 1 * 16 + cx.fr, G, dq, rope);
        do_row(acc[2][0], acc[2][1], acc[2][2], acc[2][3], row0 + cx.wr * 64 + 2 * 16 + cx.fr, G, dq, rope);
        do_row(acc[3][0], acc[3][1], acc[3][2], acc[3][3], row0 + cx.wr * 64 + 3 * 16 + cx.fr, G, dq, rope);
    }
    __device__ __forceinline__ void do_row(f32x4 v0, f32x4 v1, f32x4 v2, f32x4 v3, const int row, int G, int dq, bool rope) const {
        f32x4 c0 = {0.f, 0.f, 0.f, 0.f}, c1 = c0, s0 = c0, s1 = c0;
        if (rope) { const float* cp = (const float*)(ws + WS_ROPEC) + (size_t)row * 32 + dq; const float* sp = (const float*)(ws + WS_ROPES) + (size_t)row * 32 + dq;
            c0 = *(const f32x4*)cp; c1 = *(const f32x4*)(cp + 16); s0 = *(const f32x4*)sp; s1 = *(const f32x4*)(sp + 16); }
        do_row_r(v0, v1, v2, v3, row, G, dq, rope, c0, c1, s0, s1);
    }
    __device__ __forceinline__ void do_row_r(f32x4 v0, f32x4 v1, f32x4 v2, f32x4 v3, const int row, int G, int dq, bool rope, f32x4 c0, f32x4 c1, f32x4 s0, f32x4 s1) const {
        {
            const int b = row >> 11, t = row & (S - 1);
            f32x4 v[4] = {v0, v1, v2, v3};
            if (G >= 28 && G < 36) { bf16* dst = (bf16*)(ws + WS_NQU) + (((size_t)b * 8 + (G - 28)) * S + t) * 64 + dq;
#pragma unroll
                for (int n = 0; n < 4; ++n) { v[n] = v[n] * NSA_QS; st4bf(dst + n * 16, v[n]); } }
            if (rope) {
                { const f32x4 lo = v[0], hi = v[2]; v[0] = lo * c0 - hi * s0; v[2] = hi * c0 + lo * s0; }
                { const f32x4 lo = v[1], hi = v[3]; v[1] = lo * c1 - hi * s1; v[3] = hi * c1 + lo * s1; }
            }
            bf16* dst = nullptr; bf16* tdst = nullptr;
            if (G < 4) dst = (bf16*)(ws + WS_PRQ) + (((size_t)b * 4 + G) * S + t) * 64;
            else if (G < 8) { dst = (bf16*)(ws + WS_PRK) + (((size_t)b * 4 + (G - 4)) * S + t) * 64;
#pragma unroll
                for (int n = 0; n < 4; ++n) v[n] = v[n] * 0.125f; }
            else if (G < 12) dst = (bf16*)(ws + WS_PRV) + (((size_t)b * 4 + (G - 8)) * S + t) * 64;
            else if (G < 16) dst = (bf16*)(ws + WS_RG) + (size_t)row * 256 + (G - 12) * 64;
            else if (G < 28) dst = (bf16*)(ws + WS_CV) + (size_t)row * 768 + (G - 16) * 64;
            else if (G < 36) dst = (bf16*)(ws + WS_NQRB) + (((size_t)b * 8 + (G - 28)) * S + t) * 64;
            else if (G < 38) dst = (bf16*)(ws + WS_NKC) + (((size_t)b * 2 + (G - 36)) * S + t) * 64;
            else if (G < 40) dst = (bf16*)(ws + WS_NVC) + (((size_t)b * 2 + (G - 38)) * S + t) * 64;
            else if (G < 42) dst = (bf16*)(ws + WS_NKS) + (((size_t)b * 2 + (G - 40)) * S + t) * 64;
            else if (G < 44) tdst = (bf16*)(ws + WS_NVST) + (((size_t)b * 2 + (G - 42)) * 64) * S + t;
            else if (G < 46) dst = (bf16*)(ws + WS_NKW) + (((size_t)b * 2 + (G - 44)) * S + t) * 64;
            else if (G < 48) tdst = (bf16*)(ws + WS_NVWT) + (((size_t)b * 2 + (G - 46)) * 64) * S + t;
            if (dst) {
#pragma unroll
                for (int n = 0; n < 4; ++n) st4bf(dst + n * 16 + dq, v[n]);
            } else if (tdst) {
#pragma unroll
                for (int n = 0; n < 4; ++n)
#pragma unroll
                    for (int j = 0; j < 4; ++j) tdst[(size_t)(n * 16 + dq + j) * S] = (bf16)(cvt_pk_bf16(v[n][j], v[n][j]) & 0xffffu);
            } else {
                float* ng = (float*)(ws + WS_NG) + (size_t)row * 24;
#pragma unroll
                for (int n = 0; n < 2; ++n)
#pragma unroll
                    for (int j = 0; j < 4; ++j) { const int d = n * 16 + dq + j; if (d < 24) ng[d] = sigmoidf_(v[n][j]); }
            }
        }
    }
};
struct EpiGU {
    bf16* ACT; const float* bias; int pbase, nvalid, ct;
    __device__ __forceinline__ void operator()(const f32x4 (&acc)[4][4], const GemmCtx& cx) const {
#pragma unroll
        for (int m = 0; m < 4; ++m) { const int r = cx.wr * 64 + m * 16 + cx.fr; if (r >= nvalid) continue;
#pragma unroll
            for (int np = 0; np < 2; ++np) {
                const int col = ct * 64 + cx.wc * 32 + np * 16 + cx.fq * 4;
                const f32x4 bg = *(const f32x4*)(bias + col), bu = *(const f32x4*)(bias + 1024 + col);
                const f32x4 g = acc[m][2 * np] + bg, u = acc[m][2 * np + 1] + bu;
                float o[4];
#pragma unroll
                for (int j = 0; j < 4; ++j) { const float gc = fminf(g[j], 7.f), uc = fminf(fmaxf(u[j], -7.f), 7.f); o[j] = (uc + 1.f) * (gc * sigmoidf_(1.702f * gc)); }
                u32x2 w; w.x = cvt_pk_bf16(o[0], o[1]); w.y = cvt_pk_bf16(o[2], o[3]);
                *(u32x2*)(ACT + (size_t)(pbase + r) * FF + col) = w; } }
    }
};
struct EpiDN {
    float* YK; const float* bias; const int* list; const float* gatew; int nvalid, col0;
    __device__ __forceinline__ void operator()(const f32x4 (&acc)[4][4], const GemmCtx& cx) const {
#pragma unroll
        for (int m = 0; m < 4; ++m) { const int r = cx.wr * 64 + m * 16 + cx.fr; if (r >= nvalid) continue;
            const int slot = list[r]; const float w = gatew[slot];
#pragma unroll
            for (int n = 0; n < 4; ++n) { const int col = col0 + cx.wc * 64 + n * 16 + cx.fq * 4;
                const f32x4 bv = *(const f32x4*)(bias + col);
                *(f32x4*)(YK + (size_t)slot * D + col) = (acc[m][n] + bv) * w; } }
    }
};


struct EpiIn2 {
    static constexpr bool PREFETCH = false;
    unsigned char* ws;
    __device__ __forceinline__ void row(f32x4 v0, f32x4 v1, f32x4 v2, f32x4 v3, const int row, int G, int d0, bool rope, f32x4 c0, f32x4 c1, f32x4 s0, f32x4 s1) const {
        const int b = row >> 11, t = row & (S - 1);
        if (G >= 28 && G < 36) { bf16* dst = (bf16*)(ws + WS_NQU) + (((size_t)b * 8 + (G - 28)) * S + t) * 64 + d0;
            v0 = v0 * NSA_QS; v1 = v1 * NSA_QS; v2 = v2 * NSA_QS; v3 = v3 * NSA_QS; st8bf(dst, v0, v1); st8bf(dst + 32, v2, v3); }
        if (rope) {
            { const f32x4 lo = v0, hi = v2; v0 = lo * c0 - hi * s0; v2 = hi * c0 + lo * s0; }
            { const f32x4 lo = v1, hi = v3; v1 = lo * c1 - hi * s1; v3 = hi * c1 + lo * s1; }
        }
        bf16* dst = nullptr; bf16* tdst = nullptr;
        if (G < 4) dst = (bf16*)(ws + WS_PRQ) + (((size_t)b * 4 + G) * S + t) * 64;
        else if (G < 8) { dst = (bf16*)(ws + WS_PRK) + (((size_t)b * 4 + (G - 4)) * S + t) * 64; v0 = v0 * 0.125f; v1 = v1 * 0.125f; v2 = v2 * 0.125f; v3 = v3 * 0.125f; }
        else if (G < 12) dst = (bf16*)(ws + WS_PRV) + (((size_t)b * 4 + (G - 8)) * S + t) * 64;
        else if (G < 16) dst = (bf16*)(ws + WS_RG) + (size_t)row * 256 + (G - 12) * 64;
        else if (G < 28) dst = (bf16*)(ws + WS_CV) + (size_t)row * 768 + (G - 16) * 64;
        else if (G < 36) dst = (bf16*)(ws + WS_NQRB) + (((size_t)b * 8 + (G - 28)) * S + t) * 64;
        else if (G < 38) dst = (bf16*)(ws + WS_NKC) + (((size_t)b * 2 + (G - 36)) * S + t) * 64;
        else if (G < 40) dst = (bf16*)(ws + WS_NVC) + (((size_t)b * 2 + (G - 38)) * S + t) * 64;
        else if (G < 42) dst = (bf16*)(ws + WS_NKS) + (((size_t)b * 2 + (G - 40)) * S + t) * 64;
        else if (G < 44) tdst = (bf16*)(ws + WS_NVST) + (((size_t)b * 2 + (G - 42)) * 64) * S + t;
        else if (G < 46) dst = (bf16*)(ws + WS_NKW) + (((size_t)b * 2 + (G - 44)) * S + t) * 64;
        else tdst = (bf16*)(ws + WS_NVWT) + (((size_t)b * 2 + (G - 46)) * 64) * S + t;
        if (dst) { st8bf(dst + d0, v0, v1); st8bf(dst + 32 + d0, v2, v3); }
        else {
#pragma unroll
            for (int j = 0; j < 4; ++j) {
                tdst[(size_t)(d0 + j) * S] = (bf16)(cvt_pk_bf16(v0[j], v0[j]) & 0xffffu); tdst[(size_t)(d0 + 4 + j) * S] = (bf16)(cvt_pk_bf16(v1[j], v1[j]) & 0xffffu);
                tdst[(size_t)(32 + d0 + j) * S] = (bf16)(cvt_pk_bf16(v2[j], v2[j]) & 0xffffu); tdst[(size_t)(36 + d0 + j) * S] = (bf16)(cvt_pk_bf16(v3[j], v3[j]) & 0xffffu); }
        }
    }
    __device__ __forceinline__ void operator()(const f32x4 (&acc)[2][2][4][2], const pg8::Unit& u, int wr, int wc, int fr, int fq) const {
        const int G = 4 * u.pn + wc, d0 = fq * 8;
        const bool rope = (G < 8) || (G >= 28 && G < 36) || G == 40 || G == 41 || G == 44 || G == 45;
#pragma unroll
        for (int ai = 0; ai < 2; ++ai) {
            const int rb = u.pm * 256 + 128 * ai + 64 * wr + fr;
#pragma unroll
            for (int mp = 0; mp < 2; ++mp) {
                f32x4 c0[2], c1[2], s0[2], s1[2];
#pragma unroll
                for (int m = 0; m < 2; ++m) { c0[m] = (f32x4){0.f, 0.f, 0.f, 0.f}; c1[m] = c0[m]; s0[m] = c0[m]; s1[m] = c0[m]; }
                if (rope) {
#pragma unroll
                    for (int m = 0; m < 2; ++m) { const float* cp = (const float*)(ws + WS_ROPEC) + (size_t)(rb + 16 * (2 * mp + m)) * 32 + d0; const float* sp = (const float*)(ws + WS_ROPES) + (size_t)(rb + 16 * (2 * mp + m)) * 32 + d0;
                        c0[m] = *(const f32x4*)cp; c1[m] = *(const f32x4*)(cp + 4); s0[m] = *(const f32x4*)sp; s1[m] = *(const f32x4*)(sp + 4); } }
                row(acc[ai][0][2 * mp][0], acc[ai][0][2 * mp][1], acc[ai][1][2 * mp][0], acc[ai][1][2 * mp][1], rb + 32 * mp, G, d0, rope, c0[0], c1[0], s0[0], s1[0]);
                row(acc[ai][0][2 * mp + 1][0], acc[ai][0][2 * mp + 1][1], acc[ai][1][2 * mp + 1][0], acc[ai][1][2 * mp + 1][1], rb + 32 * mp + 16, G, d0, rope, c0[1], c1[1], s0[1], s1[1]);
            }
        }
    }
};
struct EpiOut2 {
    static constexpr bool PREFETCH = false;
    bf16* C;
    __device__ __forceinline__ void operator()(const f32x4 (&acc)[2][2][4][2], const pg8::Unit& u, int wr, int wc, int fr, int fq) const {
#pragma unroll
        for (int ai = 0; ai < 2; ++ai)
#pragma unroll
            for (int m = 0; m < 4; ++m) { bf16* rp = C + (size_t)(u.pm * 256 + 128 * ai + 64 * wr + 16 * m + fr) * D + u.pn * 256 + 32 * wc + 8 * fq;
#pragma unroll
                for (int bj = 0; bj < 2; ++bj) st8bf(rp + 128 * bj, acc[ai][bj][m][0], acc[ai][bj][m][1]); }
    }
};
constexpr int SB_OFF = pg8::NA_OFF + 8192;
struct EpiGU2 {
    static constexpr bool PREFETCH = true;
    unsigned char* ACT; const float* bias_l; const float* lhs; float winv;
    __device__ __forceinline__ void prefetch(LAS unsigned char* lds, const pg8::Unit& u, int tid) const {
        const int wv = __builtin_amdgcn_readfirstlane(tid >> 6), i = tid & 255;
        const float* g = tid < 256 ? lhs + (size_t)u.e * T + u.lrow0 + (i < u.nvalid ? i : u.nvalid - 1)
                                   : bias_l + (size_t)u.e * 2048 + 128 * u.pn + (i < 128 ? i : 1024 + (i - 128));
        __builtin_amdgcn_global_load_lds((const unsigned*)g, (LAS unsigned*)(lds + SB_OFF + wv * 256), 4, 0, 0);
    }
    __device__ __forceinline__ void operator()(const f32x4 (&acc)[2][2][4][2], const pg8::Unit& u, int wr, int wc, int fr, int fq, LAS unsigned char* lds) const {
        const LAS float* SC = (const LAS float*)(lds + SB_OFF); const LAS float* BI = SC + 256 + 32 * wc + 8 * fq;
        float sc[2][4];
#pragma unroll
        for (int ai = 0; ai < 2; ++ai)
#pragma unroll
            for (int m = 0; m < 4; ++m) sc[ai][m] = SC[128 * ai + 64 * wr + 16 * m + fr] * winv;
        f32x4 bg[2], bu[2];
#pragma unroll
        for (int n = 0; n < 2; ++n) { bg[n] = *(const LAS f32x4*)(BI + 4 * n); bu[n] = *(const LAS f32x4*)(BI + 128 + 4 * n); }
        float kexp = -1.702f * 1.4426950408889634f, one = 1.f, qs = ACT_QS; asm volatile("" : "+v"(kexp), "+v"(one), "+v"(qs));
#pragma unroll
        for (int ai = 0; ai < 2; ++ai)
#pragma unroll
            for (int mp = 0; mp < 2; ++mp) {
                u32x2 pk[2];
#pragma unroll
                for (int mm = 0; mm < 2; ++mm) { const int m = 2 * mp + mm;
#pragma unroll
                    for (int n = 0; n < 2; ++n) {
                        const f32x4 g = acc[ai][0][m][n] * sc[ai][m] + bg[n], uu = acc[ai][1][m][n] * sc[ai][m] + bu[n];
                        const f32x4 gc = __builtin_elementwise_min(g, (f32x4){7.f, 7.f, 7.f, 7.f});
                        const f32x4 uc = __builtin_elementwise_min(__builtin_elementwise_max(uu, (f32x4){-7.f, -7.f, -7.f, -7.f}), (f32x4){7.f, 7.f, 7.f, 7.f});
                        const f32x4 x = gc * kexp; f32x4 e;
#pragma unroll
                        for (int j = 0; j < 4; ++j) e[j] = __builtin_amdgcn_exp2f(x[j]);
                        const f32x4 dn = e + one; f32x4 rr;
#pragma unroll
                        for (int j = 0; j < 4; ++j) rr[j] = __builtin_amdgcn_rcpf(dn[j]);
                        const f32x4 o = (uc * qs + qs) * (gc * rr);
                        if (n == 0) pk[mm].x = pk4_fp8(o); else pk[mm].y = pk4_fp8(o); } }
                const auto sx = __builtin_amdgcn_permlane16_swap(pk[0].x, pk[1].x, false, false), sy = __builtin_amdgcn_permlane16_swap(pk[0].y, pk[1].y, false, false);
                const int r = 128 * ai + 64 * wr + 16 * (2 * mp + (fq & 1)) + fr;
                if (r < u.nvalid) *(u32x4*)(ACT + (size_t)(u.pm * 256 + r) * FF + 128 * u.pn + 32 * wc + 8 * (fq & ~1)) = (u32x4){(unsigned)sx[0], (unsigned)sy[0], (unsigned)sx[1], (unsigned)sy[1]};
            }
    }
};
struct EpiDN2 {
    static constexpr bool PREFETCH = true;
    bf16* YK; const float* bias_l; const int* list; const float* lgw; float dq;
    __device__ __forceinline__ void prefetch(LAS unsigned char* lds, const pg8::Unit& u, int tid) const {
        const int wv = __builtin_amdgcn_readfirstlane(tid >> 6), i = tid & 255;
        const size_t ri = (size_t)u.e * T + u.lrow0 + (i < u.nvalid ? i : u.nvalid - 1);
        if (wv < 4) {
            __builtin_amdgcn_global_load_lds((const unsigned*)(list + ri), (LAS unsigned*)(lds + SB_OFF + wv * 256), 4, 0, 0);
            __builtin_amdgcn_global_load_lds((const unsigned*)(lgw + ri), (LAS unsigned*)(lds + SB_OFF + 1024 + wv * 256), 4, 0, 0);
        } else
            __builtin_amdgcn_global_load_lds((const unsigned*)(bias_l + (size_t)u.e * D + 256 * u.pn + i), (LAS unsigned*)(lds + SB_OFF + 2048 + (wv - 4) * 256), 4, 0, 0);
    }
    __device__ __forceinline__ void operator()(const f32x4 (&acc)[2][2][4][2], const pg8::Unit& u, int wr, int wc, int fr, int fq, LAS unsigned char* lds) const {
        const LAS int* SL = (const LAS int*)(lds + SB_OFF) + 64 * wr + fr; const LAS float* GW = (const LAS float*)(lds + SB_OFF + 1024) + 64 * wr + fr;
        const LAS float* BI = (const LAS float*)(lds + SB_OFF + 2048) + 32 * wc + 8 * fq;
        int slot[2][4]; float gw[2][4];
#pragma unroll
        for (int ai = 0; ai < 2; ++ai)
#pragma unroll
            for (int m = 0; m < 4; ++m) { slot[ai][m] = SL[128 * ai + 16 * m]; gw[ai][m] = GW[128 * ai + 16 * m]; }
        f32x4 bv[2][2];
#pragma unroll
        for (int bj = 0; bj < 2; ++bj)
#pragma unroll
            for (int n = 0; n < 2; ++n) bv[bj][n] = *(const LAS f32x4*)(BI + 128 * bj + 4 * n);
#pragma unroll
        for (int ai = 0; ai < 2; ++ai)
#pragma unroll
            for (int m = 0; m < 4; ++m) { const int r = 128 * ai + 64 * wr + 16 * m + fr; if (r >= u.nvalid) continue;
#pragma unroll
                for (int bj = 0; bj < 2; ++bj) { const int col = 256 * u.pn + 128 * bj + 32 * wc + 8 * fq;
                    const f32x4 v0 = (acc[ai][bj][m][0] * dq + bv[bj][0]) * gw[ai][m], v1 = (acc[ai][bj][m][1] * dq + bv[bj][1]) * gw[ai][m];
                    u32x4 o; o.x = cvt_pk_bf16(v0.x, v0.y); o.y = cvt_pk_bf16(v0.z, v0.w); o.z = cvt_pk_bf16(v1.x, v1.y); o.w = cvt_pk_bf16(v1.z, v1.w);
                    *(u32x4*)(YK + (size_t)slot[ai][m] * D + col) = o; } }
    }
};

__device__ __forceinline__ void phase_gemm_in(const Frame& F, int l) {
    pg8::StaticOrder So; So.init(T, 3072, F.G, F.bid);
    pg8::gemm_phase<false>(F.lds, (const bf16*)(F.ws + WS_H), pg8::ADense{}, pg8::BDense{(const bf16*)(F.ws + WS_WIN) + (size_t)l * NINP * D}, So, EpiIn2{(unsigned char*)F.ws}, F.tid);
}
__device__ __forceinline__ void phase_gemm_out(const Frame& F, int l) {
    pg8::StaticOrder So; So.init(T, D, F.G, F.bid);
    pg8::gemm_phase<false>(F.lds, (const bf16*)(F.ws + WS_Y), pg8::ADense{}, pg8::BDense{(const bf16*)(F.ws + WS_WOUT) + (size_t)l * D * D}, So, EpiOut2{(bf16*)(F.ws + WS_MIX)}, F.tid);
}
__device__ __forceinline__ void moe_tables(const Frame& F, int l) {
    volatile LAS int* M = (volatile LAS int*)(F.lds + LDS_MISC);
    __syncthreads();
    if (F.tid < 64) {
        const int e = F.lane & 31; const int c = (int)((const unsigned*)(F.ws + WS_CTL) + CW_CNT + l * NE)[e];
        const int tl = (c + 255) >> 8; int inc = tl;
#pragma unroll
        for (int d = 1; d < 32; d <<= 1) { const int o = __shfl_up(inc, d, 32); if (e >= d) inc += o; }
        if (F.lane < 32) { M[16 + e] = c; M[48 + e] = inc - tl; if (e == 31) M[48 + NE] = inc; }
    }
    __syncthreads();
}
template <int WHICH> __device__ __forceinline__ void phase_moe(const Frame& F, int l) {
    constexpr int NCT = WHICH == 0 ? 8 : 4;
    moe_tables(F, l);
    volatile LAS int* M = (volatile LAS int*)(F.lds + LDS_MISC);
    const pg8::MoeOrder So{M, NCT, M[48 + NE] * NCT, F.G, F.bid};
    const int* list = (const int*)(F.ws + WS_LIST);
    const float* wmax = (const float*)((const unsigned*)(F.ws + WS_CTL) + CW_WMAX) + l * 2;
    if (WHICH == 0)
        pg8::gemm_phase<true>(F.lds, (const void*)(F.ws + WS_HQ), pg8::AGather{list}, pg8::BExpert8{(const unsigned char*)(F.ws + WS_WGU) + (size_t)l * NE * 2048 * D, (size_t)2048 * D}, So,
                              EpiGU2{(unsigned char*)(F.ws + WS_ACT), F.in[17] + (size_t)l * NE * 2048, (const float*)(F.ws + WS_LHS), 1.f / w_qscale(wmax[0])}, F.tid);
    else
        pg8::gemm_phase<true>(F.lds, (const void*)(F.ws + WS_ACT), pg8::ADense{}, pg8::BExpert8{(const unsigned char*)(F.ws + WS_WDN) + (size_t)l * NE * D * FF, (size_t)D * FF}, So,
                              EpiDN2{(bf16*)(F.ws + WS_YK), F.in[19] + (size_t)l * NE * D, list, (const float*)(F.ws + WS_LGW), 1.f / (ACT_QS * w_qscale(wmax[1]))}, F.tid);
}


__constant__ float c_log_gamma[4] = {-0.0317486983145803f, -0.015748356968139168f, -0.007843177461025893f, -0.003913899321136329f};
constexpr int RL_Q = 0, RL_K = 16384, RL_KT = 32768, RL_VT = 49152, RL_SP = 65536, RL_ST = 98304;
__device__ __forceinline__ void ret_stage(const Frame& F, int b, int h, int n, bool full, float lg) {
    LAS unsigned char* L = F.lds;
    const int tk = F.tid >> 2, part = F.tid & 3;
    const size_t rowoff = (((size_t)b * 4 + h) * S + n * 128 + tk) * 64 + part * 16;
    const u32x4* kp = (const u32x4*)((const bf16*)(F.ws + WS_PRK) + rowoff);
    const u32x4* vp = (const u32x4*)((const bf16*)(F.ws + WS_PRV) + rowoff);
    const u32x4 k0 = kp[0], k1 = kp[1], v0 = vp[0], v1 = vp[1];
    if (full) { const u32x4* qp = (const u32x4*)((const bf16*)(F.ws + WS_PRQ) + rowoff);
        const u32x4 q0 = qp[0], q1 = qp[1];
        *(LAS u32x4*)(L + RL_Q + tk * 128 + part * 32) = q0; *(LAS u32x4*)(L + RL_Q + tk * 128 + part * 32 + 16) = q1;
        *(LAS u32x4*)(L + RL_K + tk * 128 + part * 32) = k0; *(LAS u32x4*)(L + RL_K + tk * 128 + part * 32 + 16) = k1; }
    const float kd = expf((float)(127 - tk) * lg);
    const unsigned kw[8] = {k0.x, k0.y, k0.z, k0.w, k1.x, k1.y, k1.z, k1.w}, vw[8] = {v0.x, v0.y, v0.z, v0.w, v1.x, v1.y, v1.z, v1.w};
#pragma unroll
    for (int i = 0; i < 8; ++i) { const int d = part * 16 + 2 * i;
        if (!full) { const unsigned pk = cvt_pk_bf16(bf2f((unsigned short)(kw[i] & 0xffffu)) * kd, bf2f((unsigned short)(kw[i] >> 16)) * kd);
            *(LAS unsigned short*)(L + RL_KT + (d * 128 + tk) * 2) = (unsigned short)(pk & 0xffffu); *(LAS unsigned short*)(L + RL_KT + ((d + 1) * 128 + tk) * 2) = (unsigned short)(pk >> 16); }
        *(LAS unsigned short*)(L + RL_VT + (d * 128 + tk) * 2) = (unsigned short)(vw[i] & 0xffffu); *(LAS unsigned short*)(L + RL_VT + ((d + 1) * 128 + tk) * 2) = (unsigned short)(vw[i] >> 16); }
}
__device__ __forceinline__ void ret_kv_unit(const Frame& F, int unit) {
    const int n = unit & 15, h = (unit >> 4) & 3, b = unit >> 6;
    const float lg = c_log_gamma[h];
    LAS unsigned char* L = F.lds;
    __syncthreads();
    ret_stage(F, b, h, n, false, lg);
    __syncthreads();
    const int fr = F.lane & 15, fq = F.lane >> 4, dtile = F.wave >> 1, et0 = (F.wave & 1) * 2;
    f32x4 a0 = {0.f, 0.f, 0.f, 0.f}, a1 = {0.f, 0.f, 0.f, 0.f};
#pragma unroll
    for (int ks = 0; ks < 4; ++ks) {
        const bf16x8 a = *(const LAS bf16x8*)(L + RL_KT + ((16 * dtile + fr) * 128 + 32 * ks + fq * 8) * 2);
        const bf16x8 b0 = *(const LAS bf16x8*)(L + RL_VT + ((16 * et0 + fr) * 128 + 32 * ks + fq * 8) * 2);
        const bf16x8 b1 = *(const LAS bf16x8*)(L + RL_VT + ((16 * (et0 + 1) + fr) * 128 + 32 * ks + fq * 8) * 2);
        a0 = __builtin_amdgcn_mfma_f32_16x16x32_bf16(a, b0, a0, 0, 0, 0); a1 = __builtin_amdgcn_mfma_f32_16x16x32_bf16(a, b1, a1, 0, 0, 0);
    }
    float* kv = (float*)(F.ws + WS_KVB) + ((((size_t)b * 4 + h) * 16 + n) * 64) * 64;
#pragma unroll
    for (int j = 0; j < 4; ++j) { const int d = 16 * dtile + fq * 4 + j; kv[d * 64 + 16 * et0 + fr] = a0[j]; kv[d * 64 + 16 * (et0 + 1) + fr] = a1[j]; }
}
__device__ __forceinline__ void ret_out_unit(const Frame& F, int l, int unit) {
    const int n = unit & 15, h = (unit >> 4) & 3, b = unit >> 6;
    const float lg = c_log_gamma[h];
    LAS unsigned char* L = F.lds;
    __syncthreads();
    ret_stage(F, b, h, n, true, lg);
    {
        const int idx8 = F.tid * 8, d = idx8 >> 6, e0 = idx8 & 63;
        f32x4 s0 = {0.f, 0.f, 0.f, 0.f}, s1 = {0.f, 0.f, 0.f, 0.f};
        const float* kvb = (const float*)(F.ws + WS_KVB) + (((size_t)b * 4 + h) * 16) * 4096 + idx8;
#pragma unroll
        for (int mb = 0; mb < 16; mb += 8) {
            f32x4 t0[8], t1[8];
#pragma unroll
            for (int q = 0; q < 8; ++q) { const int m = mb + q; const bool ok = m < n;
                t0[q] = ok ? *(const f32x4*)(kvb + (size_t)m * 4096) : (f32x4){0.f, 0.f, 0.f, 0.f}; t1[q] = ok ? *(const f32x4*)(kvb + (size_t)m * 4096 + 4) : (f32x4){0.f, 0.f, 0.f, 0.f}; }
#pragma unroll
            for (int q = 0; q < 8; ++q) { const int m = mb + q; const float coef = m < n ? __expf((float)(n - 1 - m) * 128.f * lg) : 0.f; s0 += coef * t0[q]; s1 += coef * t1[q]; }
        }
        const unsigned p0 = cvt_pk_bf16(s0.x, s0.y), p1 = cvt_pk_bf16(s0.z, s0.w), p2 = cvt_pk_bf16(s1.x, s1.y), p3 = cvt_pk_bf16(s1.z, s1.w);
        const unsigned pk[4] = {p0, p1, p2, p3};
#pragma unroll
        for (int i = 0; i < 4; ++i) { *(LAS unsigned short*)(L + RL_ST + ((e0 + 2 * i) * 64 + d) * 2) = (unsigned short)(pk[i] & 0xffffu); *(LAS unsigned short*)(L + RL_ST + ((e0 + 2 * i + 1) * 64 + d) * 2) = (unsigned short)(pk[i] >> 16); }
    }
    __syncthreads();
    const int fr = F.lane & 15, fq = F.lane >> 4, w = F.wave, i0 = 16 * w;
    for (int jt = 0; jt <= (w | 1); ++jt) {
        f32x4 acc = {0.f, 0.f, 0.f, 0.f};
#pragma unroll
        for (int ks = 0; ks < 2; ++ks) {
            const bf16x8 a = *(const LAS bf16x8*)(L + RL_Q + ((i0 + fr) * 64 + 32 * ks + fq * 8) * 2);
            const bf16x8 bb = *(const LAS bf16x8*)(L + RL_K + ((16 * jt + fr) * 64 + 32 * ks + fq * 8) * 2);
            acc = __builtin_amdgcn_mfma_f32_16x16x32_bf16(a, bb, acc, 0, 0, 0);
        }
#pragma unroll
        for (int j = 0; j < 4; ++j) { const int i = i0 + fq * 4 + j, jj = 16 * jt + fr;
            const float val = i >= jj ? acc[j] * expf((float)(i - jj) * lg) : 0.f;
            *(LAS unsigned short*)(L + RL_SP + (i * 128 + jj) * 2) = (unsigned short)(cvt_pk_bf16(val, val) & 0xffffu); }
    }
    LDS_WAIT();
    f32x4 acc1[4], acc2[4];
#pragma unroll
    for (int dt = 0; dt < 4; ++dt) { acc1[dt] = (f32x4){0.f, 0.f, 0.f, 0.f}; acc2[dt] = (f32x4){0.f, 0.f, 0.f, 0.f}; }
    for (int ks = 0; ks <= (w >> 1); ++ks) {
        const bf16x8 a = *(const LAS bf16x8*)(L + RL_SP + ((i0 + fr) * 128 + 32 * ks + fq * 8) * 2);
#pragma unroll
        for (int dt = 0; dt < 4; ++dt) { const bf16x8 bb = *(const LAS bf16x8*)(L + RL_VT + ((16 * dt + fr) * 128 + 32 * ks + fq * 8) * 2);
            acc1[dt] = __builtin_amdgcn_mfma_f32_16x16x32_bf16(a, bb, acc1[dt], 0, 0, 0); }
    }
#pragma unroll
    for (int ks = 0; ks < 2; ++ks) {
        const bf16x8 a = *(const LAS bf16x8*)(L + RL_Q + ((i0 + fr) * 64 + 32 * ks + fq * 8) * 2);
#pragma unroll
        for (int dt = 0; dt < 4; ++dt) { const bf16x8 bb = *(const LAS bf16x8*)(L + RL_ST + ((16 * dt + fr) * 64 + 32 * ks + fq * 8) * 2);
            acc2[dt] = __builtin_amdgcn_mfma_f32_16x16x32_bf16(a, bb, acc2[dt], 0, 0, 0); }
    }
    const float* gnw = F.in[5] + l * 256 + h * 64;
#pragma unroll
    for (int j = 0; j < 4; ++j) {
        const int i = i0 + fq * 4 + j; const float qd = expf((float)(i + 1) * lg);
        float o[4], sm = 0.f;
#pragma unroll
        for (int dt = 0; dt < 4; ++dt) { o[dt] = acc1[dt][j] + qd * acc2[dt][j]; sm += o[dt]; }
        sm += __shfl_xor(sm, 1); sm += __shfl_xor(sm, 2); sm += __shfl_xor(sm, 4); sm += __shfl_xor(sm, 8);
        const float mean = sm * (1.f / 64.f); float vs = 0.f;
#pragma unroll
        for (int dt = 0; dt < 4; ++dt) { o[dt] -= mean; vs += o[dt] * o[dt]; }
        vs += __shfl_xor(vs, 1); vs += __shfl_xor(vs, 2); vs += __shfl_xor(vs, 4); vs += __shfl_xor(vs, 8);
        const float rstd = 1.f / sqrtf(vs * (1.f / 64.f) + LN_EPS);
        const size_t tok = (size_t)b * S + n * 128 + i;
#pragma unroll
        for (int dt = 0; dt < 4; ++dt) { const int e = 16 * dt + fr;
            const float rg = bf2f(((const bf16*)(F.ws + WS_RG))[tok * 256 + h * 64 + e]);
            const float yv = o[dt] * rstd * gnw[e] * (rg * sigmoidf_(rg));
            ((bf16*)(F.ws + WS_Y))[tok * D + h * 64 + e] = (bf16)(cvt_pk_bf16(yv, yv) & 0xffffu); }
    }
}
__device__ __forceinline__ void conv_tokens(const Frame& F, int l, int wg0) {
    const int gw = (F.bid - wg0) * NWAVES + F.wave, NGW = (F.G - wg0) * NWAVES, lane = F.lane;
    const bf16* CV = (const bf16*)(F.ws + WS_CV); bf16* Y = (bf16*)(F.ws + WS_Y);
    const float* cw = F.in[6] + (size_t)l * 3 * 256 + lane * 4;
    const f32x4 w0 = *(const f32x4*)cw, w1 = *(const f32x4*)(cw + 256), w2 = *(const f32x4*)(cw + 512);
    for (int tok0 = gw; tok0 < T; tok0 += 4 * NGW) {
        u32x2 c[4][3], hh[4][3], bb[4];
#pragma unroll
        for (int q = 0; q < 4; ++q) { const int tok = tok0 + q * NGW; const int t = tok & (S - 1);
            const bf16* p = CV + (size_t)(tok < T ? tok : gw) * 768 + lane * 4;
            bb[q] = *(const u32x2*)p;
#pragma unroll
            for (int k = 0; k < 3; ++k) { const bf16* pk = p - (size_t)(t >= k ? k : 0) * 768; c[q][k] = *(const u32x2*)(pk + 256); hh[q][k] = *(const u32x2*)(pk + 512); } }
#pragma unroll
        for (int q = 0; q < 4; ++q) { const int tok = tok0 + q * NGW; const int t = tok & (S - 1);
            if (tok >= T) continue;
            f32x4 u[3];
#pragma unroll
            for (int k = 0; k < 3; ++k) { const f32x4 m = bf4(c[q][k]) * bf4(hh[q][k]); u[k] = t >= k ? m : (f32x4){0.f, 0.f, 0.f, 0.f}; }
            st4bf(Y + (size_t)tok * D + 256 + lane * 4, bf4(bb[q]) * (w0 * u[2] + w1 * u[1] + w2 * u[0]));
        }
    }
}

typedef float f32x16 __attribute__((ext_vector_type(16)));
typedef short s16x4 __attribute__((ext_vector_type(4)));
#define MFMA32(a, b, c) __builtin_amdgcn_mfma_f32_32x32x16_bf16((a), (b), (c), 0, 0, 0)
__device__ __forceinline__ bf16x8 pack_step(const f32x16& x, int s) {
    u32x4 p;
    asm volatile("v_cvt_pk_bf16_f32 %0, %4, %5\n\tv_cvt_pk_bf16_f32 %1, %6, %7\n\tv_cvt_pk_bf16_f32 %2, %8, %9\n\tv_cvt_pk_bf16_f32 %3, %10, %11\n\ts_nop 1"
                 : "=&v"(p[0]), "=&v"(p[1]), "=&v"(p[2]), "=&v"(p[3])
                 : "v"(x[8 * s]), "v"(x[8 * s + 1]), "v"(x[8 * s + 2]), "v"(x[8 * s + 3]), "v"(x[8 * s + 4]), "v"(x[8 * s + 5]), "v"(x[8 * s + 6]), "v"(x[8 * s + 7]));
    return __builtin_bit_cast(bf16x8, p);
}
constexpr int NL_KC = 0, NL_VC = 18432  , NL_OUT = 54272;

constexpr float NSA_DEFER = 8.f;
constexpr int NL_SLOT = 17920;
struct NsaBr { const bf16* Kp; const bf16* Vp; int srow, spart, r, h, t, qt, jlo; unsigned selmask; bool hiw; };
#define NSA_PRIO_ON(c) do { if ((c).hiw) __builtin_amdgcn_s_setprio(3); else __builtin_amdgcn_s_setprio(1); } while (0)
#define NSA_PRIO_OFF() __builtin_amdgcn_s_setprio(0)
template <int BR> __device__ __forceinline__ void nsa_s_tile(LAS unsigned char* L, int slot, const NsaBr& c, const bf16x8 (&qr)[4], f32x16 (&sa)[2]) {
    NSA_PRIO_ON(c);
#pragma unroll
    for (int kt = 0; kt < 2; ++kt) {
#pragma unroll
        for (int i = 0; i < 16; ++i) sa[kt][i] = 0.f;
#pragma unroll
        for (int ks = 0; ks < 4; ++ks) { const bf16x8 a = *(const LAS bf16x8*)(L + slot + (32 * kt + c.r) * 144 + (16 * ks + 8 * c.h) * 2); sa[kt] = MFMA32(a, qr[ks], sa[kt]); }
    }
    NSA_PRIO_OFF();
}
template <int BR> __device__ __forceinline__ void nsa_softmax_pv(LAS unsigned char* L, int slot, const NsaBr& c, int j, f32x16 (&sa)[2], f32x16 (&oacc)[2], float& mrun, float& lrun) {
    const int h = c.h, r = c.r, t = c.t;
    const bool mine = BR == 1 ? ((c.selmask >> j) & 1u) != 0u : true;
    float mblk = -1e30f;
    const bool edge = (j == c.qt) || (BR == 2 && c.qt >= 8 && j == c.jlo);
    if (edge) {
#pragma unroll
        for (int kt = 0; kt < 2; ++kt)
#pragma unroll
            for (int i = 0; i < 16; ++i) { const int key = 64 * j + 32 * kt + (i & 3) + 8 * (i >> 2) + 4 * h;
                int pb = (t - key) >> 31;
                if (BR == 2) pb |= (key - (t - 511)) >> 31;
                const float v = sa[kt][i] + __int_as_float(pb & (int)0xF149F2CA); sa[kt][i] = v; mblk = fmaxf(mblk, v); }
    } else {
#pragma unroll
        for (int kt = 0; kt < 2; ++kt)
#pragma unroll
            for (int i = 0; i < 16; i += 2) mblk = fmaxf(mblk, fmaxf(sa[kt][i], sa[kt][i + 1]));
    }
    if (BR == 1) mblk = mine ? mblk : -1e30f;
    mblk = fmaxf(mblk, __shfl_xor(mblk, 32));
    if (__any(mblk > mrun + NSA_DEFER)) {
        const float mnew = fmaxf(mrun, mblk);
        const float alpha = __builtin_amdgcn_exp2f(mrun - mnew);
        lrun *= alpha; mrun = mnew;
#pragma unroll
        for (int i = 0; i < 16; ++i) { oacc[0][i] *= alpha; oacc[1][i] *= alpha; }
    }
    const float msub = (BR == 1 && !mine) ? 1e30f : mrun;
    f32x2 ps2 = {0.f, 0.f}; float nmsub = -msub; asm volatile("" : "+v"(nmsub)); const f32x2 nm2 = {nmsub, nmsub};
#pragma unroll
    for (int kt = 0; kt < 2; ++kt) {
#pragma unroll
        for (int i = 0; i < 16; i += 2) { const f32x2 x = (f32x2){sa[kt][i], sa[kt][i + 1]} + nm2; sa[kt][i] = __builtin_amdgcn_exp2f(x.x); sa[kt][i + 1] = __builtin_amdgcn_exp2f(x.y); }
#pragma unroll
        for (int i = 0; i < 16; i += 2) ps2 += (f32x2){sa[kt][i], sa[kt][i + 1]};
    }
    const float psum = ps2.x + ps2.y;
    lrun += psum;
    NSA_PRIO_ON(c);
#pragma unroll
    for (int kt = 0; kt < 2; ++kt)
#pragma unroll
        for (int s2 = 0; s2 < 2; ++s2) { const bf16x8 pf = pack_step(sa[kt], s2);
#pragma unroll
            for (int dt = 0; dt < 2; ++dt) { const LAS unsigned char* vp = L + slot + 9216 + (32 * dt + r) * 136 + (32 * kt + 16 * s2 + 4 * h) * 2;
                const s16x4 lo = *(const LAS s16x4*)vp, hi = *(const LAS s16x4*)(vp + 16);
                const bf16x8 vf = __builtin_shufflevector(lo, hi, 0, 1, 2, 3, 4, 5, 6, 7);
                oacc[dt] = MFMA32(vf, pf, oacc[dt]); } }
    NSA_PRIO_OFF();
}
__device__ __forceinline__ void nsa_kv_load(const NsaBr& c, int j, u32x4& kreg, u32x4& vreg) {
    kreg = *(const u32x4*)(c.Kp + (size_t)(64 * j + c.srow) * 64 + c.spart * 8); vreg = *(const u32x4*)(c.Vp + (size_t)c.srow * S + 64 * j + c.spart * 8);
}
__device__ __forceinline__ void nsa_kv_write(LAS unsigned char* L, int slot, const NsaBr& c, const u32x4& kreg, const u32x4& vreg) {
    *(LAS u32x4*)(L + slot + c.srow * 144 + c.spart * 16) = kreg;
    LAS u32x2* vd = (LAS u32x2*)(L + slot + 9216 + c.srow * 136 + c.spart * 16); vd[0] = (u32x2){vreg.x, vreg.y}; vd[1] = (u32x2){vreg.z, vreg.w};
}
template <int BR> __device__ __forceinline__ void nsa_step(LAS unsigned char* L, const NsaBr& c, const bf16x8 (&qr)[4], int jj, int nblk, int s_cur, int s_nxt, int s_wr,
                                                            u32x4& kreg, u32x4& vreg, f32x16 (&cur)[2], f32x16 (&nxt)[2], f32x16 (&oacc)[2], float& mrun, float& lrun) {
    LDS_BARRIER();
    if (jj + 2 < nblk) { nsa_kv_write(L, s_wr, c, kreg, vreg); if (jj + 3 < nblk) nsa_kv_load(c, c.jlo + jj + 3, kreg, vreg); }
    if (jj + 1 < nblk) nsa_s_tile<BR>(L, s_nxt, c, qr, nxt);
    nsa_softmax_pv<BR>(L, s_cur, c, c.jlo + jj, cur, oacc, mrun, lrun);
}
template <int BR>
__device__ __forceinline__ void nsa_branch(const Frame& F, int plane, int qt, int t, int r, int h, unsigned selmask, const bf16x8 (&qr)[4], float gate) {
    LAS unsigned char* L = F.lds;
    NsaBr c;
    c.Kp = (const bf16*)(F.ws + (BR == 1 ? WS_NKS : WS_NKW)) + (size_t)plane * S * 64;
    c.Vp = (const bf16*)(F.ws + (BR == 1 ? WS_NVST : WS_NVWT)) + (size_t)plane * 64 * S;
    c.jlo = BR == 1 ? 0 : (qt > 8 ? qt - 8 : 0); c.srow = F.tid >> 3; c.spart = F.tid & 7; c.r = r; c.h = h; c.t = t; c.qt = qt; c.selmask = selmask; c.hiw = F.wave < 4;
    const int nblk = qt - c.jlo + 1;
    u32x4 kreg, vreg;
    f32x16 oacc[2], sa[2], sb[2];
#pragma unroll
    for (int i = 0; i < 16; ++i) { oacc[0][i] = 0.f; oacc[1][i] = 0.f; }
    float mrun = -1e20f, lrun = 0.f;
    nsa_kv_load(c, c.jlo, kreg, vreg);
    LDS_BARRIER();
    nsa_kv_write(L, 0, c, kreg, vreg);
    if (nblk > 1) nsa_kv_load(c, c.jlo + 1, kreg, vreg);
    LDS_BARRIER();
    if (nblk > 1) { nsa_kv_write(L, NL_SLOT, c, kreg, vreg); if (nblk > 2) nsa_kv_load(c, c.jlo + 2, kreg, vreg); }
    nsa_s_tile<BR>(L, 0, c, qr, sa);
    int s0 = 0, s1 = NL_SLOT, s2 = 2 * NL_SLOT;
#pragma unroll 1
    for (int jj = 0; jj < nblk; jj += 2) {
        nsa_step<BR>(L, c, qr, jj, nblk, s0, s1, s2, kreg, vreg, sa, sb, oacc, mrun, lrun);
        if (jj + 1 < nblk) nsa_step<BR>(L, c, qr, jj + 1, nblk, s1, s2, s0, kreg, vreg, sb, sa, oacc, mrun, lrun);
        const int tmp = s0; s0 = s2; s2 = s1; s1 = tmp;
    }
    const float ltot = lrun + __shfl_xor(lrun, 32);
    const float sc = ltot > 0.f ? gate / ltot : 0.f;
    LAS float* ob = (LAS float*)(L + NL_OUT + F.wave * 8192) + F.lane;
#pragma unroll
    for (int i = 0; i < 16; ++i) { ob[i * 64] += oacc[0][i] * sc; ob[(16 + i) * 64] += oacc[1][i] * sc; }
}

__device__ __forceinline__ void nsa_unit(const Frame& F, int plane, int qt) {
    LAS unsigned char* L = F.lds;
    const int lane = F.lane, r = lane & 31, h = lane >> 5, w = F.wave;
    const int b = plane >> 1, kvh = plane & 1, g = r & 3, head = kvh * 4 + g;
    const int t = qt * 64 + w * 8 + (r >> 2), cur = qt;
    const size_t tok = (size_t)b * S + t;
    const size_t qoff = (((size_t)b * 8 + head) * S + t) * 64 + 8 * h;
    const float* ng = (const float*)(F.ws + WS_NG) + tok * 24 + head * 3;
    const float gate_c = ng[0], gate_s = ng[1], gate_w = ng[2];
    unsigned selmask = 0u;
    __syncthreads();
    { const int row = F.tid >> 2, part = F.tid & 3;
      const u32x4* src = (const u32x4*)((const bf16*)(F.ws + WS_KCB) + ((size_t)plane * 128 + row) * 64 + part * 16);
      *(LAS u32x4*)(L + NL_KC + row * 144 + part * 32) = src[0]; *(LAS u32x4*)(L + NL_KC + row * 144 + part * 32 + 16) = src[1];
      const int d = F.tid >> 3, p8 = F.tid & 7;
      const u32x4* sv = (const u32x4*)((const bf16*)(F.ws + WS_VCT) + ((size_t)plane * 64 + d) * 128 + p8 * 16);
      *(LAS u32x4*)(L + NL_VC + d * 272 + p8 * 32) = sv[0]; *(LAS u32x4*)(L + NL_VC + d * 272 + p8 * 32 + 16) = sv[1]; }
    __syncthreads();
    {
        bf16x8 qu[4];
#pragma unroll
        for (int ks = 0; ks < 4; ++ks) qu[ks] = *(const bf16x8*)((const bf16*)(F.ws + WS_NQU) + qoff + 16 * ks);
        const int cmax = (t - 31) >> 4;
        float mx = -1e20f;
#pragma unroll
        for (int ct = 0; ct < 4; ++ct) {
            f32x16 sc;
#pragma unroll
            for (int i = 0; i < 16; ++i) sc[i] = 0.f;
#pragma unroll
            for (int ks = 0; ks < 4; ++ks) { const bf16x8 a = *(const LAS bf16x8*)(L + NL_KC + (32 * ct + r) * 144 + (16 * ks + 8 * h) * 2); sc = MFMA32(a, qu[ks], sc); }
#pragma unroll
            for (int i = 0; i < 16; ++i) { const int c = 32 * ct + (i & 3) + 8 * (i >> 2) + 4 * h; mx = fmaxf(mx, sc[i] + __int_as_float(((cmax - c) >> 31) & (int)0xF149F2CA)); }
        }
        mx = fmaxf(mx, __shfl_xor(mx, 32));
        float imp[16];
        float ls = 0.f, prev = 0.f;
        f32x16 outacc[2];
#pragma unroll
        for (int i = 0; i < 16; ++i) { outacc[0][i] = 0.f; outacc[1][i] = 0.f; }
#pragma unroll
        for (int ct = 0; ct < 4; ++ct) {
            f32x16 sc;
#pragma unroll
            for (int i = 0; i < 16; ++i) sc[i] = 0.f;
#pragma unroll
            for (int ks = 0; ks < 4; ++ks) { const bf16x8 a = *(const LAS bf16x8*)(L + NL_KC + (32 * ct + r) * 144 + (16 * ks + 8 * h) * 2); sc = MFMA32(a, qu[ks], sc); }
#pragma unroll
            for (int i = 0; i < 16; ++i) { const int c = 32 * ct + (i & 3) + 8 * (i >> 2) + 4 * h; const float e = __builtin_amdgcn_exp2f(sc[i] + __int_as_float(((cmax - c) >> 31) & (int)0xF149F2CA) - mx); sc[i] = e; ls += e; }
#pragma unroll
            for (int q = 0; q < 4; ++q) { const float ok = __shfl_xor(sc[4 * q + 3], 32);
                imp[4 * ct + q] = ((sc[4 * q] + sc[4 * q + 1]) + (sc[4 * q + 2] + sc[4 * q + 3])) + (h ? ok : prev); prev = ok; }
#pragma unroll
            for (int s2 = 0; s2 < 2; ++s2) { const bf16x8 pf = pack_step(sc, s2);
#pragma unroll
                for (int dt = 0; dt < 2; ++dt) { const LAS unsigned char* vp = L + NL_VC + (32 * dt + r) * 272 + (32 * ct + 16 * s2 + 4 * h) * 2;
                    const s16x4 lo = *(const LAS s16x4*)vp, hi = *(const LAS s16x4*)(vp + 16);
                    const bf16x8 vf = __builtin_shufflevector(lo, hi, 0, 1, 2, 3, 4, 5, 6, 7);
                    outacc[dt] = MFMA32(vf, pf, outacc[dt]); } }
            __builtin_amdgcn_sched_barrier(0);
        }
        ls += __shfl_xor(ls, 32);
        const float inv = ls > 0.f ? 1.f / ls : 0.f;
#pragma unroll
        for (int k = 0; k < 16; ++k) imp[k] *= inv;
        { LAS float* ob = (LAS float*)(L + NL_OUT + w * 8192) + lane; const float og = inv * gate_c;
#pragma unroll
          for (int i = 0; i < 16; ++i) { ob[i * 64] = outacc[0][i] * og; ob[(16 + i) * 64] = outacc[1][i] * og; } }
#pragma unroll
        for (int k = 0; k < 16; ++k) { imp[k] += __shfl_xor(imp[k], 1); imp[k] += __shfl_xor(imp[k], 2);
            const int jb = 2 * k + h; imp[k] = (jb == 0 || jb == cur) ? 1e9f : (jb <= cur ? imp[k] : -1e9f); }
#pragma unroll 1
        for (int round = 0; round < 8; ++round) {
            float bv = imp[0]; int bj = h;
#pragma unroll
            for (int k = 1; k < 16; ++k) { const bool tk = imp[k] > bv; bv = tk ? imp[k] : bv; bj = tk ? 2 * k + h : bj; }
            const float ov = __shfl_xor(bv, 32); const int oj = __shfl_xor(bj, 32);
            const bool take = (ov > bv) || (ov == bv && oj < bj);
            bj = take ? oj : bj;
            selmask |= 1u << bj;
#pragma unroll
            for (int k = 0; k < 16; ++k) imp[k] = (2 * k + h == bj) ? -INFINITY : imp[k];
        }
    }
    bf16x8 qr[4];
#pragma unroll
    for (int ks = 0; ks < 4; ++ks) qr[ks] = *(const bf16x8*)((const bf16*)(F.ws + WS_NQRB) + qoff + 16 * ks);
    nsa_branch<1>(F, plane, qt, t, r, h, selmask, qr, gate_s);
    nsa_branch<2>(F, plane, qt, t, r, h, 0u, qr, gate_w);
    bf16* yp = (bf16*)(F.ws + WS_Y) + tok * D + 512 + head * 64;
    { const LAS float* ob = (const LAS float*)(L + NL_OUT + w * 8192) + lane;
#pragma unroll
      for (int dt = 0; dt < 2; ++dt)
#pragma unroll
        for (int q = 0; q < 4; ++q) st4bf(yp + 32 * dt + 8 * q + 4 * h, (f32x4){ob[(16 * dt + 4 * q) * 64], ob[(16 * dt + 4 * q + 1) * 64], ob[(16 * dt + 4 * q + 2) * 64], ob[(16 * dt + 4 * q + 3) * 64]}); }
}

constexpr int CL_HD = 49152;
struct RowCmp { int p0; __device__ __forceinline__ int operator()(int r) const { return (p0 + (r >> 7)) * 128 + (r & 127); } };
struct EpiCmp {
    LAS unsigned char* lds; unsigned char* ws; const float* bias1; const bf16* w2t; int which, p0, wave;
    __device__ __forceinline__ void operator()(const f32x4 (&acc)[4][4], const GemmCtx& cx) const {
        __syncthreads();
#pragma unroll
        for (int m = 0; m < 4; ++m) { const int rr = cx.wr * 64 + m * 16 + cx.fr;
#pragma unroll
            for (int n = 0; n < 4; ++n) { const int col = cx.wc * 64 + n * 16 + cx.fq * 4; const f32x4 bv = *(const f32x4*)(bias1 + col);
                f32x4 x = acc[m][n] + bv, o;
#pragma unroll
                for (int j = 0; j < 4; ++j) { const float xv = x[j]; o[j] = 0.5f * xv * (1.f + tanhf(0.7978845608028654f * (xv + 0.044715f * xv * xv * xv))); }
                u32x2 pk; pk.x = cvt_pk_bf16(o[0], o[1]); pk.y = cvt_pk_bf16(o[2], o[3]);
                *(LAS u32x2*)(lds + CL_HD + rr * 272 + col * 2) = pk; } }
        __syncthreads();
        f32x4 o2[2][4];
#pragma unroll
        for (int mt = 0; mt < 2; ++mt)
#pragma unroll
            for (int nt = 0; nt < 4; ++nt) o2[mt][nt] = (f32x4){0.f, 0.f, 0.f, 0.f};
#pragma unroll
        for (int ks = 0; ks < 4; ++ks) {
            bf16x8 a[2], bq[4];
#pragma unroll
            for (int mt = 0; mt < 2; ++mt) a[mt] = *(const LAS bf16x8*)(lds + CL_HD + (32 * wave + 16 * mt + cx.fr) * 272 + (32 * ks + cx.fq * 8) * 2);
#pragma unroll
            for (int nt = 0; nt < 4; ++nt) bq[nt] = *(const bf16x8*)(w2t + (16 * nt + cx.fr) * 128 + 32 * ks + cx.fq * 8);
#pragma unroll
            for (int mt = 0; mt < 2; ++mt)
#pragma unroll
                for (int nt = 0; nt < 4; ++nt) o2[mt][nt] = __builtin_amdgcn_mfma_f32_16x16x32_bf16(bq[nt], a[mt], o2[mt][nt], 0, 0, 0);
        }
#pragma unroll
        for (int mt = 0; mt < 2; ++mt) { const int rr = 32 * wave + 16 * mt + cx.fr, plane = p0 + (rr >> 7), c = rr & 127;
#pragma unroll
            for (int nt = 0; nt < 4; ++nt) { const int d0 = 16 * nt + cx.fq * 4;
                if (which == 0) st4bf((bf16*)(ws + WS_KCB) + ((size_t)plane * 128 + c) * 64 + d0, o2[mt][nt]);
                else {
#pragma unroll
                    for (int j = 0; j < 4; ++j) ((bf16*)(ws + WS_VCT))[((size_t)plane * 64 + d0 + j) * 128 + c] = (bf16)(cvt_pk_bf16(o2[mt][nt][j], o2[mt][nt][j]) & 0xffffu); } } }
    }
};

__device__ __forceinline__ void gates_tiles(const Frame& F, int l, int wg0) {
    const int NGW = (F.G - wg0) * NWAVES, gw = NGW - 1 - ((F.bid - wg0) * NWAVES + F.wave), fr = F.lane & 15, fq = F.lane >> 4;
    const bf16* H = (const bf16*)(F.ws + WS_H); const bf16* WG = (const bf16*)(F.ws + WS_WIN) + ((size_t)l * NINP + 3072) * D;
    for (int rt = gw; rt < T / 16; rt += NGW) {
        f32x4 a0 = {0.f, 0.f, 0.f, 0.f}, a1 = {0.f, 0.f, 0.f, 0.f};
        const bf16* ap = H + (size_t)(16 * rt + fr) * D + 8 * fq; const bf16* bp = WG + (size_t)fr * D + 8 * fq;
#pragma unroll 8
        for (int ks = 0; ks < 32; ++ks) { const bf16x8 a = *(const bf16x8*)(ap + 32 * ks), b0 = *(const bf16x8*)(bp + 32 * ks), b1 = *(const bf16x8*)(bp + 16 * D + 32 * ks);
            a0 = __builtin_amdgcn_mfma_f32_16x16x32_bf16(b0, a, a0, 0, 0, 0); a1 = __builtin_amdgcn_mfma_f32_16x16x32_bf16(b1, a, a1, 0, 0, 0); }
        float* ng = (float*)(F.ws + WS_NG) + (size_t)(16 * rt + fr) * 24;
#pragma unroll
        for (int j = 0; j < 4; ++j) { ng[4 * fq + j] = sigmoidf_(a0[j]); if (fq < 2) ng[16 + 4 * fq + j] = sigmoidf_(a1[j]); }
    }
}
__device__ __forceinline__ void phase_prep(const Frame& F, int l) {
    if (FAST_RET && FAST_NSA) {
        const int first = F.G > 32 ? 16 : 0;
        if (F.bid < first || first == 0) {
            for (int u = F.bid; u < 16; u += F.G) { const int which = u >> 3, p0 = (u & 7) * 2, lw = l * 2 + which;
                RowCmp R{p0}; EpiCmp E{F.lds, (unsigned char*)F.ws, (const float*)(F.ws + WS_CB1) + lw * 128, (const bf16*)(F.ws + WS_CW2T) + (size_t)lw * 64 * 128, which, p0, F.wave};
                gemm_unit(F, (const bf16*)(F.ws + (which ? WS_NVC : WS_NKC)), R, (const bf16*)(F.ws + WS_CW1T) + (size_t)lw * 128 * 2048, E, 64, 2048); }
            __syncthreads();
        }
        if (F.bid >= first) {
            conv_tokens(F, l, first); for (int u = F.bid - first; u < NB * 4 * 16; u += F.G - first) ret_kv_unit(F, u); __syncthreads();
            gates_tiles(F, l, first);
            fp8_convert_range(F, l, F.bid - first, F.G - first, CONV_SPLIT);
        }
        return;
    }
    const int gw = F.bid * NWAVES + F.wave, NGW = F.G * NWAVES, lane = F.lane;
    const float* PROJ = (const float*)(F.ws + WS_PROJ);
    float* RQ = (float*)(F.ws + WS_RQ); float* RK = (float*)(F.ws + WS_RK); float* NQR = (float*)(F.ws + WS_NQR);
    float* KSR = (float*)(F.ws + WS_KSR); float* KWR = (float*)(F.ws + WS_KWR); bf16* Y = (bf16*)(F.ws + WS_Y);
    for (int tok = gw; tok < T; tok += NGW) {
        const int t = tok & (S - 1);
        const float* p = PROJ + (size_t)tok * PLD;
        const float cv = ((const float*)(F.ws + WS_ROPEC))[tok * 32 + (lane & 31)], sv = ((const float*)(F.ws + WS_ROPES))[tok * 32 + (lane & 31)];
        const float sg = lane < 32 ? -sv : sv;
#define ROPE(v) ((v) * cv + __shfl_xor((v), 32) * sg)
        if (!FAST_RET) {
#pragma unroll
        for (int h = 0; h < 4; ++h) { const float q = p[C_RQ + h * 64 + lane], k = p[C_RK + h * 64 + lane];
            RQ[(size_t)tok * 256 + h * 64 + lane] = ROPE(q); RK[(size_t)tok * 256 + h * 64 + lane] = ROPE(k) * 0.125f; } }
#pragma unroll
        for (int h = 0; h < 8; ++h) { const float q = p[C_NQ + h * 64 + lane]; NQR[(size_t)tok * 512 + h * 64 + lane] = ROPE(q); }
#pragma unroll
        for (int h = 0; h < 2; ++h) { const float a = p[C_NKS + h * 64 + lane], b2 = p[C_NKW + h * 64 + lane];
            KSR[(size_t)tok * 128 + h * 64 + lane] = ROPE(a); KWR[(size_t)tok * 128 + h * 64 + lane] = ROPE(b2); }
#undef ROPE
        const float* cw = F.in[6] + (size_t)l * 3 * 256;
        if (!FAST_RET)
#pragma unroll
        for (int i = 0; i < 4; ++i) { const int ch = lane + 64 * i;
            const float u0 = p[C_CC + ch] * p[C_CH + ch];
            const float u1 = t >= 1 ? (p - PLD)[C_CC + ch] * (p - PLD)[C_CH + ch] : 0.f;
            const float u2 = t >= 2 ? (p - 2 * PLD)[C_CC + ch] * (p - 2 * PLD)[C_CH + ch] : 0.f;
            const float yv = cw[ch] * u2 + cw[256 + ch] * u1 + cw[512 + ch] * u0;
            const float o = p[C_CB + ch] * yv;
            const float on = __shfl_down(o, 1);
            if ((lane & 1) == 0) *(unsigned*)(Y + (size_t)tok * D + 256 + ch) = cvt_pk_bf16(o, on); }
    }
    LAS float* sc = (LAS float*)(F.lds + F.wave * 16384);
    LAS float* xs = sc; LAS float* hs = sc + 3072;
    for (int unit = gw; unit < 2 * NB * 2 * 64; unit += NGW) {
        const int cp = unit & 63, kvh = (unit >> 6) & 1, b = (unit >> 7) & 7, which = unit >> 10;
        const int c = 2 * cp, col = (which ? C_NVC : C_NKC) + kvh * 64;
        for (int tt = 0; tt < 48; ++tt) { const int tp = 16 * c + tt; xs[tt * 64 + lane] = tp < S ? PROJ[((size_t)b * S + tp) * PLD + col + lane] : 0.f; }
        const float* pos = F.in[7] + ((size_t)l * 2 + which) * 2048;
        const float* w1 = F.in[8] + ((size_t)l * 2 + which) * 2048 * 128;
        const float* w2 = F.in[9] + ((size_t)l * 2 + which) * 128 * 64;
        float a00 = 0.f, a01 = 0.f, a10 = 0.f, a11 = 0.f;
#pragma unroll 4
        for (int k = 0; k < 2048; ++k) { const float pv = pos[k], wa = w1[(size_t)k * 128 + lane], wb = w1[(size_t)k * 128 + 64 + lane];
            const float x0 = xs[k] + pv, x1 = xs[1024 + k] + pv;
            a00 += x0 * wa; a01 += x0 * wb; a10 += x1 * wa; a11 += x1 * wb; }
#define GELU_T(x) (0.5f * (x) * (1.f + tanhf(0.7978845608028654f * ((x) + 0.044715f * (x) * (x) * (x)))))
        hs[lane] = GELU_T(a00); hs[64 + lane] = GELU_T(a01); hs[128 + lane] = GELU_T(a10); hs[192 + lane] = GELU_T(a11);
#undef GELU_T
        float o0 = 0.f, o1 = 0.f;
        for (int n = 0; n < 128; ++n) { const float wv = w2[n * 64 + lane]; o0 += hs[n] * wv; o1 += hs[128 + n] * wv; }
        float* dst = (float*)(F.ws + (which ? WS_VC : WS_KC));
        dst[(((size_t)b * 128 + c) * 2 + kvh) * 64 + lane] = o0;
        if (c + 1 < 127) dst[(((size_t)b * 128 + c + 1) * 2 + kvh) * 64 + lane] = o1;
        LDS_WAIT();
    }
}

__device__ __forceinline__ void phase_mix(const Frame& F, int l) {
    const int gw = F.bid * NWAVES + F.wave, NGW = F.G * NWAVES, lane = F.lane;
    const float* PROJ = (const float*)(F.ws + WS_PROJ);
    bf16* Y = (bf16*)(F.ws + WS_Y);
    LAS float* sc = (LAS float*)(F.lds + F.wave * 16384);
    if (FAST_RET && FAST_NSA) {
        const int cls = F.bid % 3;
        if (cls == 0) fp8_convert_range(F, l, CONV_SPLIT + F.bid, F.G, CONV_ITEMS);
        for (int u = F.bid; u < NB * 4 * 16; u += F.G) ret_out_unit(F, l, u);
        __syncthreads();
        if (cls == 1) fp8_convert_range(F, l, CONV_SPLIT + F.bid, F.G, CONV_ITEMS);
        for (int p = F.bid; p < 512; p += F.G) { const int plane = (p & 255) >> 4, pi = p & 15; nsa_unit(launder(F), plane, p < 256 ? pi : 31 - pi); }
        if (cls == 2) fp8_convert_range(F, l, CONV_SPLIT + F.bid, F.G, CONV_ITEMS);
        return;
    }
    if (FAST_RET) { for (int u = F.bid; u < NB * 4 * 16; u += F.G) ret_out_unit(F, l, u); __syncthreads(); }
    if (!FAST_RET) {
        const float* RQ = (const float*)(F.ws + WS_RQ); const float* RK = (const float*)(F.ws + WS_RK);
        LAS float* qs = sc; LAS float* wb = sc + 64;
        for (int unit = gw; unit < T * 4; unit += NGW) {
            const int h = unit & 3, tok = unit >> 2, b = tok >> 11, t = tok & (S - 1);
            const float lg = c_log_gamma[h];
            qs[lane] = RQ[(size_t)tok * 256 + h * 64 + lane];
            float o = 0.f;
            for (int s0 = 0; s0 <= t; s0 += 64) {
                const int s = s0 + lane; float w = 0.f;
                if (s <= t) { const float* kr = RK + ((size_t)b * S + s) * 256 + h * 64; float dsum = 0.f;
#pragma unroll
                    for (int d = 0; d < 64; d += 4) dsum += dot4(*(const f32x4*)(kr + d), *(const LAS f32x4*)(qs + d));
                    w = dsum * expf((float)(t - s) * lg); }
                wb[lane] = w;
                const int nk = min(64, t - s0 + 1);
                const float* vp = PROJ + ((size_t)b * S + s0) * PLD + C_RV + h * 64 + lane;
                for (int k = 0; k < nk; ++k) o += wb[k] * vp[(size_t)k * PLD];
            }
            const float mean = wsum(o) * (1.f / 64.f); const float dv = o - mean; const float var = wsum(dv * dv) * (1.f / 64.f);
            float yv = dv * (1.f / sqrtf(var + LN_EPS)) * F.in[5][l * 256 + h * 64 + lane];
            const float rg = PROJ[(size_t)tok * PLD + C_RG + h * 64 + lane];
            yv *= rg * sigmoidf_(rg);
            const float yn = __shfl_down(yv, 1);
            if ((lane & 1) == 0) *(unsigned*)(Y + (size_t)tok * D + h * 64 + lane) = cvt_pk_bf16(yv, yn);
            LDS_WAIT();
        }
    }
    if (FAST_NSA) { for (int p = F.bid; p < 512; p += F.G) { const int plane = (p & 255) >> 4, pi = p & 15; nsa_unit(launder(F), plane, p < 256 ? pi : 31 - pi); } }
    if (!FAST_NSA) {
        const float* NQR = (const float*)(F.ws + WS_NQR); const float* KSR = (const float*)(F.ws + WS_KSR); const float* KWR = (const float*)(F.ws + WS_KWR);
        const float* KC = (const float*)(F.ws + WS_KC); const float* VC = (const float*)(F.ws + WS_VC);
        LAS float* qs = sc; LAS float* qr = sc + 256; LAS float* pc = sc + 512; LAS float* ps = sc + 1024; LAS float* pw = sc + 1152;
        for (int unit = gw; unit < T * 2; unit += NGW) {
            const int kvh = unit & 1, tok = unit >> 1, b = tok >> 11, t = tok & (S - 1), cur = t >> 6;
            const float* prow = PROJ + (size_t)tok * PLD;
            const float* pb = PROJ + (size_t)b * S * PLD;
#pragma unroll
            for (int g = 0; g < 4; ++g) { qs[g * 64 + lane] = prow[C_NQ + (kvh * 4 + g) * 64 + lane]; qr[g * 64 + lane] = NQR[(size_t)tok * 512 + (kvh * 4 + g) * 64 + lane]; }
            const int c0 = lane, c1 = lane + 64;
            const bool v0 = (16 * c0 + 31 <= t), v1 = (c1 < 127) && (16 * c1 + 31 <= t);
            float s0[4], s1[4];
#pragma unroll
            for (int g = 0; g < 4; ++g) { s0[g] = 0.f; s1[g] = 0.f; }
            { const float* k0p = KC + (((size_t)b * 128 + c0) * 2 + kvh) * 64; const float* k1p = KC + (((size_t)b * 128 + c1) * 2 + kvh) * 64;
#pragma unroll 4
              for (int d = 0; d < 64; d += 4) { const f32x4 ka = *(const f32x4*)(k0p + d), kb = *(const f32x4*)(k1p + d);
#pragma unroll
                  for (int g = 0; g < 4; ++g) { const f32x4 q4 = *(const LAS f32x4*)(qs + g * 64 + d); s0[g] += dot4(ka, q4); s1[g] += dot4(kb, q4); } } }
            float psum0 = 0.f, psum1 = 0.f;
#pragma unroll
            for (int g = 0; g < 4; ++g) {
                const float a0 = v0 ? s0[g] * 0.125f : -1e30f, a1 = v1 ? s1[g] * 0.125f : -1e30f;
                const float m = wmaxf(fmaxf(a0, a1));
                const float e0 = v0 ? expf(a0 - m) : 0.f, e1 = v1 ? expf(a1 - m) : 0.f;
                const float sm = wsum(e0 + e1); const float inv = sm > 0.f ? 1.f / sm : 0.f;
                const float p0 = e0 * inv, p1 = e1 * inv;
                pc[g * 128 + c0] = p0; pc[g * 128 + c1] = p1; psum0 += p0; psum1 += p1;
            }
            ps[c0] = psum0; ps[c1] = psum1;
            LDS_WAIT();
            float oc[4] = {0.f, 0.f, 0.f, 0.f};
            const int ncv = t >= 31 ? min(127, (t - 31) / 16 + 1) : 0;
            for (int c = 0; c < ncv; ++c) { const float vv = VC[(((size_t)b * 128 + c) * 2 + kvh) * 64 + lane];
#pragma unroll
                for (int g = 0; g < 4; ++g) oc[g] += pc[g * 128 + c] * vv; }
            float imp = -3.0e38f; int idx = lane;
            if (lane < 32) { float a = 0.f;
#pragma unroll
                for (int q = -1; q <= 3; ++q) { const int cc = 4 * lane + q; if (cc >= 0 && cc < 127) a += ps[cc]; }
                imp = (lane == 0 || lane == cur) ? 1e9f : (lane <= cur ? a : -1e9f); }
            int sel[8];
#pragma unroll
            for (int r = 0; r < 8; ++r) { float bv = imp; int bi = idx; wargmax(bv, bi); sel[r] = bi; if (lane == bi) imp = -INFINITY; }
            float os[4] = {0.f, 0.f, 0.f, 0.f}, ow[4] = {0.f, 0.f, 0.f, 0.f};
            {
                float ss[8][4];
#pragma unroll
                for (int r = 0; r < 8; ++r) { const int blk = sel[r], key = blk * 64 + lane; const bool ok = (blk <= cur) && (key <= t);
                    float d0 = 0.f, d1 = 0.f, d2 = 0.f, d3 = 0.f;
                    if (blk <= cur) { const float* kr = KSR + ((size_t)b * S + key) * 128 + kvh * 64;
#pragma unroll 4
                        for (int d = 0; d < 64; d += 4) { const f32x4 kv = *(const f32x4*)(kr + d);
                            d0 += dot4(kv, *(const LAS f32x4*)(qr + d)); d1 += dot4(kv, *(const LAS f32x4*)(qr + 64 + d)); d2 += dot4(kv, *(const LAS f32x4*)(qr + 128 + d)); d3 += dot4(kv, *(const LAS f32x4*)(qr + 192 + d)); } }
                    ss[r][0] = ok ? d0 * 0.125f : -1e30f; ss[r][1] = ok ? d1 * 0.125f : -1e30f; ss[r][2] = ok ? d2 * 0.125f : -1e30f; ss[r][3] = ok ? d3 * 0.125f : -1e30f; }
#pragma unroll
                for (int g = 0; g < 4; ++g) { float m = ss[0][g];
#pragma unroll
                    for (int r = 1; r < 8; ++r) m = fmaxf(m, ss[r][g]);
                    m = wmaxf(m); float es = 0.f; float ev[8];
#pragma unroll
                    for (int r = 0; r < 8; ++r) { ev[r] = ss[r][g] > -1e29f ? expf(ss[r][g] - m) : 0.f; es += ev[r]; }
                    es = wsum(es); const float inv = 1.f / es;
#pragma unroll
                    for (int r = 0; r < 8; ++r) pw[g * 512 + r * 64 + lane] = ev[r] * inv; }
                LDS_WAIT();
#pragma unroll
                for (int r = 0; r < 8; ++r) { const int blk = sel[r]; if (blk > cur) continue;
                    const int nk = min(64, t - blk * 64 + 1);
                    const float* vp = pb + (size_t)(blk * 64) * PLD + C_NVS + kvh * 64 + lane;
                    for (int k = 0; k < nk; ++k) { const float vv = vp[(size_t)k * PLD];
#pragma unroll
                        for (int g = 0; g < 4; ++g) os[g] += pw[g * 512 + r * 64 + k] * vv; } }
                LDS_WAIT();
            }
            {
                float ss[8][4];
#pragma unroll
                for (int r = 0; r < 8; ++r) { const int key = t - 511 + r * 64 + lane; const bool ok = key >= 0;
                    float d0 = 0.f, d1 = 0.f, d2 = 0.f, d3 = 0.f;
                    if (ok) { const float* kr = KWR + ((size_t)b * S + key) * 128 + kvh * 64;
#pragma unroll 4
                        for (int d = 0; d < 64; d += 4) { const f32x4 kv = *(const f32x4*)(kr + d);
                            d0 += dot4(kv, *(const LAS f32x4*)(qr + d)); d1 += dot4(kv, *(const LAS f32x4*)(qr + 64 + d)); d2 += dot4(kv, *(const LAS f32x4*)(qr + 128 + d)); d3 += dot4(kv, *(const LAS f32x4*)(qr + 192 + d)); } }
                    ss[r][0] = ok ? d0 * 0.125f : -1e30f; ss[r][1] = ok ? d1 * 0.125f : -1e30f; ss[r][2] = ok ? d2 * 0.125f : -1e30f; ss[r][3] = ok ? d3 * 0.125f : -1e30f; }
#pragma unroll
                for (int g = 0; g < 4; ++g) { float m = ss[0][g];
#pragma unroll
                    for (int r = 1; r < 8; ++r) m = fmaxf(m, ss[r][g]);
                    m = wmaxf(m); float es = 0.f; float ev[8];
#pragma unroll
                    for (int r = 0; r < 8; ++r) { ev[r] = ss[r][g] > -1e29f ? expf(ss[r][g] - m) : 0.f; es += ev[r]; }
                    es = wsum(es); const float inv = 1.f / es;
#pragma unroll
                    for (int r = 0; r < 8; ++r) pw[g * 512 + r * 64 + lane] = ev[r] * inv; }
                LDS_WAIT();
                const int k0 = max(0, t - 511);
                const float* vp = pb + C_NVW + kvh * 64 + lane;
                for (int key = k0; key <= t; ++key) { const float vv = vp[(size_t)key * PLD]; const int pi = key - (t - 511);
#pragma unroll
                    for (int g = 0; g < 4; ++g) ow[g] += pw[g * 512 + pi] * vv; }
                LDS_WAIT();
            }
#pragma unroll
            for (int g = 0; g < 4; ++g) { const int head = kvh * 4 + g;
                const float g0 = sigmoidf_(prow[C_NG + head * 3 + 0]), g1 = sigmoidf_(prow[C_NG + head * 3 + 1]), g2 = sigmoidf_(prow[C_NG + head * 3 + 2]);
                const float o = g0 * oc[g] + g1 * os[g] + g2 * ow[g];
                const float on = __shfl_down(o, 1);
                if ((lane & 1) == 0) *(unsigned*)(Y + (size_t)tok * D + 512 + head * 64 + lane) = cvt_pk_bf16(o, on); }
        }
    }
}

constexpr int NPH_LAYER = 8, NPHASES = 2 + DEPTH * NPH_LAYER;

__global__ void __launch_bounds__(NTHR, 2) fwd(Args args) {
    extern __shared__ __attribute__((aligned(16))) unsigned char lds_raw[];
    Frame F;
    F.lds = (LAS unsigned char*)lds_raw; F.ws = (GAS unsigned char*)args.ws; F.out = (GAS float*)args.out; F.in = args.in;
    F.tid = threadIdx.x; F.lane = F.tid & 63; F.wave = __builtin_amdgcn_readfirstlane(F.tid >> 6); F.bid = blockIdx.x; F.G = gridDim.x;
    const bool is_t0 = (F.tid == 0);
    volatile LAS unsigned* MISC = (volatile LAS unsigned*)(F.lds + LDS_MISC);
    if (F.tid < 128) MISC[F.tid] = 0u;
    __syncthreads();
    const int lo = args.ph_lo, hi = args.ph_hi;
    const bool multi = (hi - lo) > 1;
    XcdBarrier bar; bar.bar = (unsigned*)(F.ws + WS_CTL) + CW_BAR; bar.x = 0; bar.st = MISC + 8;
    if (multi) bar = xcd_barrier_post((unsigned*)(F.ws + WS_CTL) + CW_BAR, MISC + 8, is_t0);
#ifndef PMASK
#define PMASK 0xFFFF
#endif
#ifndef REPMASK
#define REPMASK 0
#endif
#define REPS(b) (((REPMASK) & (b)) ? 2 : 1)
#define IN(k) (lo <= (k) && (k) < hi)
#define SEAM(k) do { if (IN(k) && IN((k) + 1)) xcd_barrier(bar, is_t0); } while (0)
    if ((PMASK & 1) && IN(0)) { for (int rep = 0; rep < REPS(1); ++rep) { F = launder(F); phase_p0(F); } SEAM(0); }
    if ((PMASK & 2) && IN(1)) { F = launder(F); phase_row0(F); SEAM(1); }
    for (int l = 0; l < DEPTH; ++l) {
        const int pb = 2 + l * NPH_LAYER;
        if ((PMASK & 4) && IN(pb + 0)) { for (int rep = 0; rep < REPS(4); ++rep) { F = launder(F); phase_gemm_in(F, l); if (REPS(4) > 1) __syncthreads(); } SEAM(pb + 0); }
        if ((PMASK & 8) && IN(pb + 1)) { for (int rep = 0; rep < REPS(8); ++rep) { F = launder(F); phase_prep(F, l); if (REPS(8) > 1) __syncthreads(); } SEAM(pb + 1); }
        if ((PMASK & 16) && IN(pb + 2)) { for (int rep = 0; rep < REPS(16); ++rep) { F = launder(F); phase_mix(F, l); if (REPS(16) > 1) __syncthreads(); } SEAM(pb + 2); }
        if ((PMASK & 32) && IN(pb + 3)) { for (int rep = 0; rep < REPS(32); ++rep) { F = launder(F); phase_gemm_out(F, l); if (REPS(32) > 1) __syncthreads(); } SEAM(pb + 3); }
        if ((PMASK & 64) && IN(pb + 4)) { for (int rep = 0; rep < REPS(64); ++rep) { F = launder(F); phase_row1(F, l); if (REPS(64) > 1) __syncthreads(); } SEAM(pb + 4); }
        if ((PMASK & 128) && IN(pb + 5)) { for (int rep = 0; rep < REPS(128); ++rep) { F = launder(F); phase_moe<0>(F, l); if (REPS(128) > 1) __syncthreads(); } SEAM(pb + 5); }
        if ((PMASK & 256) && IN(pb + 6)) { for (int rep = 0; rep < REPS(256); ++rep) { F = launder(F); phase_moe<1>(F, l); if (REPS(256) > 1) __syncthreads(); } SEAM(pb + 6); }
        if ((PMASK & 512) && IN(pb + 7)) { for (int rep = 0; rep < REPS(512); ++rep) { F = launder(F); phase_row2(F, l); if (REPS(512) > 1) __syncthreads(); } SEAM(pb + 7); }
    }
#undef IN
#undef SEAM
}

extern "C" void kernel_launch(void* const* d_in, const int* in_sizes, int n_in, void* d_out, int out_size, void* d_ws, size_t ws_size, hipStream_t stream) {
    static int grid = 0;
    if (grid == 0) {
        if (n_in != 20 || out_size != T * D || ws_size < WS_END) { fprintf(stderr, "kernel_launch: unexpected problem (n_in %d out %d ws %zu)\n", n_in, out_size, ws_size); grid = -1; return; }
        int dev = 0, cus = 0;
        if (hipGetDevice(&dev) != hipSuccess || hipDeviceGetAttribute(&cus, hipDeviceAttributeMultiprocessorCount, dev) != hipSuccess) { grid = -1; return; }
        if (hipFuncSetAttribute((const void*)fwd, hipFuncAttributeMaxDynamicSharedMemorySize, LDS_BYTES) != hipSuccess) { fprintf(stderr, "kernel_launch: hipFuncSetAttribute failed\n"); grid = -1; return; }
        int per_cu = 0;
        if (hipOccupancyMaxActiveBlocksPerMultiprocessor(&per_cu, (const void*)fwd, NTHR, LDS_BYTES) != hipSuccess || per_cu < 1) fprintf(stderr, "kernel_launch: occupancy query says %d\n", per_cu);
        (void)hipGetLastError();
        grid = cus;
    }
    if (grid < 0) return;
    (void)hipMemsetAsync((char*)d_ws + WS_CTL, 0, CTL_BYTES, stream);
    Args a{};
    for (int i = 0; i < 20; ++i) a.in[i] = (const float*)d_in[i];
    a.out = (float*)d_out; a.ws = (unsigned char*)d_ws;
#if ONE_LAUNCH
    a.ph_lo = 0; a.ph_hi = NPHASES;
    hipLaunchKernelGGL(fwd, dim3(grid), dim3(NTHR), LDS_BYTES, stream, a);
#else
    for (int p = 0; p < NPHASES; ++p) { a.ph_lo = p; a.ph_hi = p + 1; hipLaunchKernelGGL(fwd, dim3(grid), dim3(NTHR), LDS_BYTES, stream, a); }
#endif
}
```
